# Optimizing an MI355X kernel written in HIP

```python
import math
import jax, jax.numpy as jnp
from jax import lax
import numpy as np

D_MODEL = 1024
BATCH = 8
SEQ = 2048
DEPTH = 2

GRID_W = 64
CTX_LEN = 256
N_MIXERS = 2
M_HEADS = 4
M_DV = D_MODEL // M_HEADS
M_DK = M_DV // 2
M_CHUNK = 128
M_PROJ = 2 * M_HEADS * M_DK + 2 * M_HEADS * M_DV + 4 * M_HEADS
F_GROUPS = 8
F_GROUP_DIM = D_MODEL // F_GROUPS
FFN_DIM = 2816
CONV_W = 3
EPS = 1e-6

kernel_name = "hybrid_mlstm_fourier_dit_block"


def rmsnorm(x, g):
    x32 = x.astype(jnp.float32)
    y = x32 * lax.rsqrt(jnp.mean(x32 * x32, axis=-1, keepdims=True) + EPS)
    return (y * g.astype(jnp.float32)).astype(x.dtype)


def modulate(h, shift, scale):
    return h * (1 + scale[..., None, :]) + shift[..., None, :]


def _ctx_stream_needed(layer):
    return any(j % N_MIXERS == 0 for j in range(layer + 1, DEPTH))


def mlstm_project(h, w_in, b_in):
    B, T, _ = h.shape
    hk, hv = M_HEADS * M_DK, M_HEADS * M_DV
    p = h @ w_in + b_in
    q, k, v, o, gates = jnp.split(p, [hk, 2 * hk, 2 * hk + hv, 2 * hk + 2 * hv], axis=-1)

    def heads(t, d):
        return t.reshape(B, T, M_HEADS, d).transpose(0, 2, 1, 3).astype(jnp.float32)

    q = heads(q, M_DK)
    k = heads(k, M_DK) * (M_DK ** -0.5)
    v = heads(v, M_DV)
    g = gates.astype(jnp.float32).reshape(B, T, 4, M_HEADS).transpose(2, 0, 3, 1)
    fwd = (g[0], jax.nn.log_sigmoid(g[1]))
    bwd = (g[2], jax.nn.log_sigmoid(g[3]))
    return q, k, v, o, fwd, bwd


def mlstm_zero_state(B):
    return (jnp.zeros((B, M_HEADS, M_DK, M_DV), jnp.float32),
            jnp.zeros((B, M_HEADS, M_DK), jnp.float32),
            jnp.zeros((B, M_HEADS), jnp.float32))


def mlstm_chunk_scan(q, k, v, logi, logf, state0, with_outputs):
    B, H, T, _ = q.shape
    L = M_CHUNK
    nc = T // L

    def chunks(t):
        return jnp.moveaxis(t.reshape((B, H, nc, L) + t.shape[3:]), 2, 0)

    tri = jnp.tril(jnp.ones((L, L), dtype=bool))

    def step(carry, inp):
        C, n, m = carry
        qc, kc, vc, li, lf = inp
        b = jnp.cumsum(lf, axis=-1)
        bL = b[..., -1]
        g_s = bL[..., None] - b + li
        m_new = jnp.maximum(bL + m, jnp.max(g_s, axis=-1))
        a = jnp.exp(bL + m - m_new)
        ws = jnp.exp(g_s - m_new[..., None])
        C_new = a[..., None, None] * C + jnp.einsum('bhs,bhsd,bhse->bhde', ws, kc, vc)
        n_new = a[..., None] * n + jnp.einsum('bhs,bhsd->bhd', ws, kc)
        if not with_outputs:
            return (C_new, n_new, m_new), None
        dmat = jnp.where(tri, b[..., :, None] - b[..., None, :] + li[..., None, :], -jnp.inf)
        inter = b + m[..., None]
        m_t = jnp.maximum(inter, jnp.max(dmat, axis=-1))
        w_inter = jnp.exp(inter - m_t)
        s = jnp.einsum('bhtd,bhsd->bhts', qc, kc) * jnp.exp(dmat - m_t[..., None])
        num = w_inter[..., None] * jnp.einsum('bhtd,bhde->bhte', qc, C) + jnp.einsum('bhts,bhse->bhte', s, vc)
        den = w_inter * jnp.einsum('bhtd,bhd->bht', qc, n) + jnp.sum(s, axis=-1)
        h = num / jnp.maximum(jnp.abs(den), jnp.exp(-m_t))[..., None]
        return (C_new, n_new, m_new), h

    state, hs = lax.scan(step, state0, (chunks(q), chunks(k), chunks(v), chunks(logi), chunks(logf)))
    if with_outputs:
        hs = jnp.moveaxis(hs, 0, 2).reshape(B, H, T, M_DV)
    return hs, state


def mlstm_direction(q, k, v, gates, state0, reverse, with_outputs):
    logi, logf = gates
    if reverse:
        q, k, v = q[:, :, ::-1], k[:, :, ::-1], v[:, :, ::-1]
        logi, logf = logi[..., ::-1], logf[..., ::-1]
    h, state = mlstm_chunk_scan(q, k, v, logi, logf, state0, with_outputs)
    if reverse and with_outputs:
        h = h[:, :, ::-1]
    return h, state


def mlstm_readout(h, o, norm_g, w_out):
    B, H, T, _ = h.shape
    hn = h * lax.rsqrt(jnp.mean(h * h, axis=-1, keepdims=True) + EPS)
    hn = hn * norm_g.astype(jnp.float32).reshape(H, 1, M_DV)
    hn = hn.transpose(0, 2, 1, 3).reshape(B, T, H * M_DV)
    y = (hn * jax.nn.sigmoid(o.astype(jnp.float32))).astype(o.dtype)
    return y @ w_out


def mlstm_mixer(hx, hc, w_in, b_in, norm_g, w_out, ctx_outputs):
    B = hx.shape[0]
    s0 = mlstm_zero_state(B)
    qc, kc, vc, oc, gfc, gbc = mlstm_project(hc, w_in, b_in)
    hcf, st_f = mlstm_direction(qc, kc, vc, gfc, s0, False, ctx_outputs)
    hcb, st_b = mlstm_direction(qc, kc, vc, gbc, s0, True, ctx_outputs)
    qx, kx, vx, ox, gfx, gbx = mlstm_project(hx, w_in, b_in)
    hxf, _ = mlstm_direction(qx, kx, vx, gfx, st_f, False, True)
    hxb, _ = mlstm_direction(qx, kx, vx, gbx, st_b, True, True)
    yx = mlstm_readout(hxf + hxb, ox, norm_g, w_out)
    yc = mlstm_readout(hcf + hcb, oc, norm_g, w_out) if ctx_outputs else None
    return yx, yc


def fourier_mixer(h, w_out, b_out):
    B, T, D = h.shape
    hg = h.astype(jnp.float32).reshape(B, T, F_GROUPS, F_GROUP_DIM)
    y = jnp.real(jnp.fft.fft2(hg, axes=(1, 3), norm="ortho")).reshape(B, T, D).astype(h.dtype)
    return y @ w_out + b_out


def dwconv3(g, w, b, axis):
    n = g.shape[axis]
    pad = [(0, 0)] * g.ndim
    pad[axis] = (1, 1)
    gp = jnp.pad(g, pad)
    return (lax.slice_in_dim(gp, 0, n, axis=axis) * w[0]
            + lax.slice_in_dim(gp, 1, n + 1, axis=axis) * w[1]
            + lax.slice_in_dim(gp, 2, n + 2, axis=axis) * w[2] + b)


def conv_ffn(h, up_w, conv_w, conv_b, down_w, on_grid):
    u, g = jnp.split(h @ up_w, 2, axis=-1)
    if on_grid:
        B, T, F = g.shape
        rows = T // GRID_W
        g = dwconv3(g.reshape(B, rows, GRID_W, F), conv_w, conv_b, axis=2).reshape(B, T, F)
    else:
        g = dwconv3(g, conv_w, conv_b, axis=1)
    return (jax.nn.silu(g) * u) @ down_w


def setup_inputs(seed: int = 0) -> dict:
    key = jax.random.key(seed)
    ks = jax.random.split(key, 24)
    D, F = D_MODEL, FFN_DIM
    NA = (DEPTH + N_MIXERS - 1) // N_MIXERS
    NB = DEPTH // N_MIXERS
    nrm = jax.random.normal
    x = nrm(ks[0], (BATCH, SEQ, D), jnp.float32)
    c = nrm(ks[1], (BATCH, D), jnp.float32)
    ctx = nrm(ks[2], (BATCH, CTX_LEN, D), jnp.float32)
    c_ctx = nrm(ks[3], (D,), jnp.float32)
    ada_w = nrm(ks[4], (DEPTH, D, 6 * D), jnp.float32) * D ** -0.5
    ada_b = 0.02 * nrm(ks[5], (DEPTH, 6 * D), jnp.float32)
    pre_mix_g = 1.0 + 0.05 * nrm(ks[6], (DEPTH, D), jnp.float32)
    post_mix_g = 1.0 + 0.05 * nrm(ks[7], (DEPTH, D), jnp.float32)
    pre_ffn_g = 1.0 + 0.05 * nrm(ks[8], (DEPTH, D), jnp.float32)
    post_ffn_g = 1.0 + 0.05 * nrm(ks[9], (DEPTH, D), jnp.float32)
    ffn_up_w = nrm(ks[10], (DEPTH, D, 2 * F), jnp.float32) * D ** -0.5
    ffn_conv_w = nrm(ks[11], (DEPTH, CONV_W, F), jnp.float32) * CONV_W ** -0.5
    ffn_conv_b = 0.02 * nrm(ks[12], (DEPTH, F), jnp.float32)
    ffn_down_w = nrm(ks[13], (DEPTH, F, D), jnp.float32) * F ** -0.5
    m_in_w = nrm(ks[14], (NA, D, M_PROJ), jnp.float32) * D ** -0.5
    lin_b = 0.02 * nrm(ks[15], (NA, M_PROJ - 4 * M_HEADS), jnp.float32)
    f_base = jnp.linspace(3.0, 6.0, M_HEADS, dtype=jnp.float32)
    gn = 0.1 * nrm(ks[16], (NA, 4, M_HEADS), jnp.float32)
    gate_b = gn + jnp.stack([jnp.zeros_like(f_base), f_base, jnp.zeros_like(f_base), f_base])[None]
    m_in_b = jnp.concatenate([lin_b, gate_b.reshape(NA, 4 * M_HEADS)], axis=-1)
    m_norm_g = 1.0 + 0.05 * nrm(ks[17], (NA, M_HEADS * M_DV), jnp.float32)
    m_out_w = nrm(ks[18], (NA, M_HEADS * M_DV, D), jnp.float32) * (M_HEADS * M_DV) ** -0.5
    f_out_w = nrm(ks[19], (NB, D, D), jnp.float32) * D ** -0.5
    f_out_b = 0.02 * nrm(ks[20], (NB, D), jnp.float32)
    return {"x": x, "c": c, "ctx": ctx, "c_ctx": c_ctx,
            "ada_w": ada_w, "ada_b": ada_b,
            "pre_mix_g": pre_mix_g, "post_mix_g": post_mix_g,
            "pre_ffn_g": pre_ffn_g, "post_ffn_g": post_ffn_g,
            "ffn_up_w": ffn_up_w, "ffn_conv_w": ffn_conv_w, "ffn_conv_b": ffn_conv_b,
            "ffn_down_w": ffn_down_w,
            "m_in_w": m_in_w, "m_in_b": m_in_b, "m_norm_g": m_norm_g, "m_out_w": m_out_w,
            "f_out_w": f_out_w, "f_out_b": f_out_b}


def reference(x, c, ctx, c_ctx, ada_w, ada_b, pre_mix_g, post_mix_g, pre_ffn_g, post_ffn_g,
              ffn_up_w, ffn_conv_w, ffn_conv_b, ffn_down_w,
              m_in_w, m_in_b, m_norm_g, m_out_w, f_out_w, f_out_b):
    cx = jax.nn.silu(c)
    cc = jax.nn.silu(c_ctx)
    h_ctx = ctx
    for i in range(DEPTH):
        is_mlstm = (i % N_MIXERS) == 0
        j = i // N_MIXERS
        ctx_out = _ctx_stream_needed(i)
        sh1, sc1, g1, sh2, sc2, g2 = jnp.split(cx @ ada_w[i] + ada_b[i], 6, axis=-1)
        if is_mlstm or ctx_out:
            csh1, csc1, cg1, csh2, csc2, cg2 = jnp.split(cc @ ada_w[i] + ada_b[i], 6, axis=-1)
        hx = modulate(rmsnorm(x, pre_mix_g[i]), sh1, sc1)
        if is_mlstm:
            hc = modulate(rmsnorm(h_ctx, pre_mix_g[i]), csh1, csc1)
            yx, yc = mlstm_mixer(hx, hc, m_in_w[j], m_in_b[j], m_norm_g[j], m_out_w[j], ctx_out)
        else:
            yx = fourier_mixer(hx, f_out_w[j], f_out_b[j])
            if ctx_out:
                hc = modulate(rmsnorm(h_ctx, pre_mix_g[i]), csh1, csc1)
                yc = fourier_mixer(hc, f_out_w[j], f_out_b[j])
        x = x + g1[..., None, :] * rmsnorm(yx, post_mix_g[i])
        if ctx_out:
            h_ctx = h_ctx + cg1[..., None, :] * rmsnorm(yc, post_mix_g[i])
        hx = modulate(rmsnorm(x, pre_ffn_g[i]), sh2, sc2)
        yx = conv_ffn(hx, ffn_up_w[i], ffn_conv_w[i], ffn_conv_b[i], ffn_down_w[i], True)
        x = x + g2[..., None, :] * rmsnorm(yx, post_ffn_g[i])
        if ctx_out:
            hc = modulate(rmsnorm(h_ctx, pre_ffn_g[i]), csh2, csc2)
            yc = conv_ffn(hc, ffn_up_w[i], ffn_conv_w[i], ffn_conv_b[i], ffn_down_w[i], False)
            h_ctx = h_ctx + cg2[..., None, :] * rmsnorm(yc, post_ffn_g[i])
    return x
```

```cpp
#include <hip/hip_runtime.h>
#include <hip/hip_cooperative_groups.h>
#include <cstdio>
#include <cstdint>
namespace cg = cooperative_groups;

#ifndef MK_N_LAUNCHES
#define MK_N_LAUNCHES 16
#endif

#define GAS __attribute__((address_space(1)))
#define LAS __attribute__((address_space(3)))
typedef unsigned short bf16;
typedef float f32x4 __attribute__((ext_vector_type(4)));
typedef unsigned u32x4 __attribute__((ext_vector_type(4)));
typedef unsigned u32x2 __attribute__((ext_vector_type(2)));

constexpr int D = 1024, NB = 8, T = 2048, TC = 256;
constexpr int ML = NB * T;
constexpr int MC = NB * TC;
constexpr int MALL = ML + MC;
constexpr int NH = 4, DK = 128, DV = 256;
constexpr int NPROJ = 3088, NPROJ_PAD = 3328;
constexpr int FF = 2816, NUP = 2 * FF;
constexpr float EPS = 1e-6f;
constexpr int NPH = 16;
constexpr int NWAVES = 8, NTHR = 512;

constexpr size_t MiB = 1u << 20;
constexpr size_t WS_CTL = 0;
constexpr size_t WS_MOD = 1 * MiB;
constexpr size_t WS_WIN = 2 * MiB;
constexpr size_t WS_WOUT = WS_WIN + (size_t)NPROJ_PAD * D * 2;
constexpr size_t WS_WUP = WS_WOUT + (size_t)D * D * 2;
constexpr size_t WS_WDN = WS_WUP + (size_t)2 * NUP * D * 2;
constexpr size_t WS_WCS = WS_WDN + (size_t)2 * D * FF * 2;
constexpr size_t WS_DFT = WS_WCS + (size_t)D * 2048 * 2;
constexpr size_t WS_A = WS_DFT + (size_t)4096 * 2048 * 2;
constexpr size_t WS_C = WS_A + (size_t)MALL * D * 2;
constexpr size_t WS_B = WS_C + (size_t)ML * D * 2;
constexpr size_t WS_Q = WS_B;
constexpr size_t WS_K = WS_Q + (size_t)ML * 512 * 2;
constexpr size_t WS_V = WS_K + (size_t)MALL * 512 * 2;
constexpr size_t WS_O = WS_V + (size_t)MALL * D * 2;
constexpr size_t WS_G = WS_O + (size_t)ML * D * 2;
constexpr size_t WS_END = WS_B + 104 * MiB;
static_assert(WS_G + (size_t)MALL * 16 * 4 <= WS_END, "region B");
static_assert(WS_END <= 256 * MiB, "workspace");
constexpr size_t WS_HF = WS_A;
constexpr size_t WS_HB = WS_C;
constexpr size_t WS_Y = WS_Q;
constexpr size_t WS_Y1 = WS_V;
constexpr size_t WS_H2 = WS_A;
constexpr size_t WS_ACT = WS_B;
constexpr size_t WS_Y2 = WS_A;
constexpr size_t WS_HT = WS_B;
constexpr size_t WS_PQ = WS_B + 32 * MiB;
constexpr size_t WS_Y3 = WS_A;
constexpr size_t WS_H2B = WS_B + 72 * MiB;
constexpr size_t WS_ACT1 = WS_A;
constexpr size_t WS_Y2B = WS_B + 24 * MiB;
static_assert(WS_V + (size_t)ML * D * 4 <= WS_G, "y1 overlay");
static_assert(WS_ACT1 + (size_t)ML * FF * 2 <= WS_H2B && WS_ACT1 + (size_t)ML * FF * 2 <= WS_Y2B, "layer-1 overlays");
static_assert(WS_Y2B + (size_t)ML * D * 4 <= WS_END && WS_H2B + (size_t)ML * D * 2 <= WS_END && WS_PQ + (size_t)ML * 2048 * 2 <= WS_END, "layer-1 overlays");

constexpr int LDS_BYTES = 147456;

__device__ __forceinline__ float bf2f(unsigned v) { return __uint_as_float(v << 16); }
__device__ __forceinline__ unsigned f2bf(float f) { unsigned u = __float_as_uint(f); return (u + 0x7fffu + ((u >> 16) & 1u)) >> 16; }
__device__ __forceinline__ unsigned pk2(float lo, float hi) { return f2bf(lo) | (f2bf(hi) << 16); }
__device__ __forceinline__ float silu_f(float v) { return v / (1.f + __expf(-v)); }
__device__ __forceinline__ float sigmoid_f(float v) { return 1.f / (1.f + __expf(-v)); }
__device__ __forceinline__ float logsigmoid_f(float v) { return fminf(v, 0.f) - log1pf(__expf(-fabsf(v))); }
__device__ __forceinline__ float wave_sum(float v) {
#pragma unroll
    for (int o = 1; o < 64; o <<= 1) v += __shfl_xor(v, o);
    return v;
}

struct Args { const float* in[20]; float* out; unsigned char* ws; int ph_lo, ph_hi; };

template <int MODE>
__device__ __forceinline__ void p0_transpose_item(const float* W, int K, int N, bf16* WT, LAS float* scr, int item, int nblk, int lane) {
    const int kb = item / nblk, nb = item % nblk, k0 = 64 * kb, n0 = 32 * nb;
#pragma unroll 8
    for (int i = 0; i < 32; ++i) { const int kk = 2 * i + (lane >> 5); const int n = n0 + (lane & 31);
        scr[kk * 33 + (lane & 31)] = (n < N) ? W[(size_t)(k0 + kk) * N + n] : 0.f; }
    asm volatile("s_waitcnt lgkmcnt(0)" ::: "memory");
    const int c = lane & 7;
#pragma unroll
    for (int j = 0; j < 4; ++j) { const int nl = (lane >> 3) + 8 * j; const LAS float* s = scr + (8 * c) * 33 + nl;
        u32x4 o; o.x = pk2(s[0 * 33], s[1 * 33]); o.y = pk2(s[2 * 33], s[3 * 33]); o.z = pk2(s[4 * 33], s[5 * 33]); o.w = pk2(s[6 * 33], s[7 * 33]);
        int n = n0 + nl, dr = n;
        if (MODE == 1) { const int isg = n >= FF ? 1 : 0; const int jj = n - isg * FF; dr = (jj >> 7) * 256 + isg * 128 + (jj & 127); }
        *(u32x4*)(WT + (size_t)dr * K + k0 + 8 * c) = o; }
    asm volatile("s_waitcnt lgkmcnt(0)" ::: "memory");
}

__device__ __forceinline__ void p0_prep(const Args& a, LAS unsigned char* lds, int tid, int lane, int wave, int G) {
    unsigned char* ws = a.ws;
    {
        LAS float* scr = (LAS float*)(lds + wave * 16384);
        const int gw = blockIdx.x * NWAVES + wave, NGW = G * NWAVES;
        constexpr int I_IN = 16 * (NPROJ_PAD / 32), I_OUT = 16 * 32, I_UP = 16 * (NUP / 32), I_DN = (FF / 64) * 32;
        constexpr int NIT = I_IN + I_OUT + 2 * I_UP + 2 * I_DN;
        for (int it = gw; it < NIT; it += NGW) {
            int r = it;
            if (r < I_IN) { p0_transpose_item<0>(a.in[14], D, NPROJ, (bf16*)(ws + WS_WIN), scr, r, NPROJ_PAD / 32, lane); continue; } r -= I_IN;
            if (r < I_OUT) { p0_transpose_item<0>(a.in[17], D, D, (bf16*)(ws + WS_WOUT), scr, r, 32, lane); continue; } r -= I_OUT;
            if (r < I_UP) { p0_transpose_item<1>(a.in[10], D, NUP, (bf16*)(ws + WS_WUP), scr, r, NUP / 32, lane); continue; } r -= I_UP;
            if (r < I_UP) { p0_transpose_item<1>(a.in[10] + (size_t)D * NUP, D, NUP, (bf16*)(ws + WS_WUP) + (size_t)NUP * D, scr, r, NUP / 32, lane); continue; } r -= I_UP;
            if (r < I_DN) { p0_transpose_item<0>(a.in[13], FF, D, (bf16*)(ws + WS_WDN), scr, r, 32, lane); continue; } r -= I_DN;
            p0_transpose_item<0>(a.in[13] + (size_t)FF * D, FF, D, (bf16*)(ws + WS_WDN) + (size_t)D * FF, scr, r, 32, lane);
        }
    }
    __syncthreads();
    LAS float* tab = (LAS float*)(lds + 131072);
    for (int i = tid; i < 2048; i += NTHR) tab[i] = cospif((float)i * (1.0f / 1024.0f));
    __syncthreads();
    {
        bf16* DF = (bf16*)(ws + WS_DFT);
        const int total = 4096 * 256;
        for (int idx = blockIdx.x * NTHR + tid; idx < total; idx += G * NTHR) {
            const int r = idx >> 8, t0 = (idx & 255) * 8, tp = r & 2047, sh = (r >> 11) ? 512 : 0;
            float v[8];
#pragma unroll
            for (int j = 0; j < 8; ++j) v[j] = tab[(tp * (t0 + j) + sh) & 2047] * (1.0f / 512.0f);
            u32x4 o; o.x = pk2(v[0], v[1]); o.y = pk2(v[2], v[3]); o.z = pk2(v[4], v[5]); o.w = pk2(v[6], v[7]);
            *(u32x4*)(DF + (size_t)r * 2048 + t0) = o;
        }
    }
    {
        const float* W = a.in[18]; bf16* WCS = (bf16*)(ws + WS_WCS);
        LAS float* wt = (LAS float*)lds;
        for (int it = blockIdx.x; it < 8 * 16; it += G) {
            const int g = it >> 4, n0 = (it & 15) * 64;
            __syncthreads();
            for (int i = tid; i < 128 * 64; i += NTHR) wt[i] = W[(size_t)(g * 128 + (i >> 6)) * D + n0 + (i & 63)];
            __syncthreads();
            const int nl = tid >> 3, cgp = tid & 7;
            float ac[16], as[16];
#pragma unroll
            for (int j = 0; j < 16; ++j) { ac[j] = 0.f; as[j] = 0.f; }
            for (int cp = 0; cp < 128; ++cp) {
                const float w = wt[cp * 64 + nl];
#pragma unroll
                for (int j = 0; j < 16; ++j) { const int c = 16 * cgp + j; const int ph = (c * cp) & 127;
                    ac[j] += tab[ph * 16] * w; as[j] += tab[((ph * 16) + 1536) & 2047] * w; }
            }
            bf16* dst = WCS + (size_t)(n0 + nl) * 2048 + g * 128 + 16 * cgp;
            u32x4 o0, o1;
            o0.x = pk2(ac[0], ac[1]); o0.y = pk2(ac[2], ac[3]); o0.z = pk2(ac[4], ac[5]); o0.w = pk2(ac[6], ac[7]);
            o1.x = pk2(ac[8], ac[9]); o1.y = pk2(ac[10], ac[11]); o1.z = pk2(ac[12], ac[13]); o1.w = pk2(ac[14], ac[15]);
            *(u32x4*)dst = o0; *(u32x4*)(dst + 8) = o1;
            o0.x = pk2(as[0], as[1]); o0.y = pk2(as[2], as[3]); o0.z = pk2(as[4], as[5]); o0.w = pk2(as[6], as[7]);
            o1.x = pk2(as[8], as[9]); o1.y = pk2(as[10], as[11]); o1.z = pk2(as[12], as[13]); o1.w = pk2(as[14], as[15]);
            *(u32x4*)(dst + 1024) = o0; *(u32x4*)(dst + 1024 + 8) = o1;
        }
    }
    __syncthreads();
    {
        LAS float* sc = (LAS float*)lds;
        LAS float* red = (LAS float*)(lds + 40960);
        for (int i = tid; i < 9 * 1024; i += NTHR) { const float v = (i < 8 * 1024) ? a.in[1][i] : a.in[3][i - 8 * 1024]; sc[i] = silu_f(v); }
        __syncthreads();
        float* MOD = (float*)(ws + WS_MOD);
        for (int it = blockIdx.x; it < 2 * 96; it += G) {
            const int l = it / 96, c0 = (it % 96) * 64;
            const float* Wl = a.in[4] + (size_t)l * D * 6144 + c0 + lane;
            float acc[9];
#pragma unroll
            for (int r = 0; r < 9; ++r) acc[r] = 0.f;
            const int kb = wave * 128;
#pragma unroll 4
            for (int k = 0; k < 128; ++k) { const float w = Wl[(size_t)(kb + k) * 6144];
#pragma unroll
                for (int r = 0; r < 9; ++r) acc[r] += sc[r * 1024 + kb + k] * w; }
#pragma unroll
            for (int r = 0; r < 9; ++r) red[(wave * 9 + r) * 64 + lane] = acc[r];
            __syncthreads();
            for (int i = tid; i < 9 * 64; i += NTHR) { float s = 0.f;
#pragma unroll
                for (int w = 0; w < 8; ++w) s += red[w * 576 + i];
                const int r = i >> 6, cl = i & 63;
                MOD[((size_t)l * 9 + r) * 6144 + c0 + cl] = s + a.in[5][(size_t)l * 6144 + c0 + cl]; }
            __syncthreads();
        }
    }
}

__device__ __forceinline__ void load_row_f32(const float* p, int lane, f32x4 (&v)[4]) {
#pragma unroll
    for (int j = 0; j < 4; ++j) v[j] = *(const f32x4*)(p + 4 * lane + 256 * j);
}
__device__ __forceinline__ float row_sumsq(const f32x4 (&v)[4]) {
    float s = 0.f;
#pragma unroll
    for (int j = 0; j < 4; ++j) s += (v[j].x * v[j].x + v[j].y * v[j].y) + (v[j].z * v[j].z + v[j].w * v[j].w);
    return wave_sum(s);
}

__device__ __forceinline__ void p1_norm_mod(const Args& a, int lane, int wave, int G) {
    const float* MOD = (const float*)(a.ws + WS_MOD);
    bf16* A = (bf16*)(a.ws + WS_A);
    const float* g = a.in[6];
    const int gw = blockIdx.x * NWAVES + wave, NGW = G * NWAVES;
    for (int m = gw; m < MALL; m += NGW) {
        const float* xr = (m < ML) ? a.in[0] + (size_t)m * D : a.in[2] + (size_t)(m - ML) * D;
        const int mr = (m < ML) ? (m >> 11) : 8;
        const float* sh = MOD + (size_t)mr * 6144, * sc = sh + D;
        f32x4 v[4]; load_row_f32(xr, lane, v);
        const float rs = rsqrtf(row_sumsq(v) * (1.f / D) + EPS);
#pragma unroll
        for (int j = 0; j < 4; ++j) { const int c = 4 * lane + 256 * j;
            const f32x4 gg = *(const f32x4*)(g + c), s1 = *(const f32x4*)(sc + c), s0 = *(const f32x4*)(sh + c);
            const f32x4 h = v[j] * rs * gg * (1.f + s1) + s0;
            u32x2 o; o.x = pk2(h.x, h.y); o.y = pk2(h.z, h.w);
            *(u32x2*)(A + (size_t)m * D + c) = o; }
    }
}

__device__ __forceinline__ void p4_readout(const Args& a, int lane, int wave, int G) {
    const bf16* HF = (const bf16*)(a.ws + WS_HF); const bf16* HB = (const bf16*)(a.ws + WS_HB); const bf16* O = (const bf16*)(a.ws + WS_O);
    bf16* Y = (bf16*)(a.ws + WS_Y); const float* ng = a.in[16];
    const int gw = blockIdx.x * NWAVES + wave, NGW = G * NWAVES;
    for (int m = gw; m < ML; m += NGW) {
        const size_t off = (size_t)m * D + 16 * lane;
        const u32x4 f0 = *(const u32x4*)(HF + off), f1 = *(const u32x4*)(HF + off + 8);
        const u32x4 b0 = *(const u32x4*)(HB + off), b1 = *(const u32x4*)(HB + off + 8);
        const u32x4 o0 = *(const u32x4*)(O + off), o1 = *(const u32x4*)(O + off + 8);
        float h[16], og[16];
        const unsigned fw[8] = {f0.x, f0.y, f0.z, f0.w, f1.x, f1.y, f1.z, f1.w};
        const unsigned bw[8] = {b0.x, b0.y, b0.z, b0.w, b1.x, b1.y, b1.z, b1.w};
        const unsigned ow[8] = {o0.x, o0.y, o0.z, o0.w, o1.x, o1.y, o1.z, o1.w};
        float ss = 0.f;
#pragma unroll
        for (int j = 0; j < 8; ++j) {
            h[2 * j] = bf2f(fw[j] & 0xffffu) + bf2f(bw[j] & 0xffffu); h[2 * j + 1] = bf2f(fw[j] >> 16) + bf2f(bw[j] >> 16);
            og[2 * j] = bf2f(ow[j] & 0xffffu); og[2 * j + 1] = bf2f(ow[j] >> 16);
            ss += h[2 * j] * h[2 * j] + h[2 * j + 1] * h[2 * j + 1]; }
        ss += __shfl_xor(ss, 1); ss += __shfl_xor(ss, 2); ss += __shfl_xor(ss, 4); ss += __shfl_xor(ss, 8);
        const float rs = rsqrtf(ss * (1.f / DV) + EPS);
        unsigned w[8];
#pragma unroll
        for (int j = 0; j < 8; ++j) {
            const float y0 = h[2 * j] * rs * ng[16 * lane + 2 * j] * sigmoid_f(og[2 * j]);
            const float y1 = h[2 * j + 1] * rs * ng[16 * lane + 2 * j + 1] * sigmoid_f(og[2 * j + 1]);
            w[j] = pk2(y0, y1); }
        *(u32x4*)(Y + off) = (u32x4){w[0], w[1], w[2], w[3]}; *(u32x4*)(Y + off + 8) = (u32x4){w[4], w[5], w[6], w[7]};
    }
}

template <int NEXT>
__device__ __forceinline__ void rowpass(const float* Y, const float* xin, float* xout, const float* gate  , const float* post_g,
                                        const float* ng, const float* shp, const float* scp, bf16* Hout, int lane, int wave, int G) {
    const int gw = blockIdx.x * NWAVES + wave, NGW = G * NWAVES;
    for (int m = gw; m < ML; m += NGW) {
        const int b = m >> 11;
        f32x4 y[4], x[4]; load_row_f32(Y + (size_t)m * D, lane, y); load_row_f32(xin + (size_t)m * D, lane, x);
        const float rs = rsqrtf(row_sumsq(y) * (1.f / D) + EPS);
#pragma unroll
        for (int j = 0; j < 4; ++j) { const int c = 4 * lane + 256 * j;
            const f32x4 gt = *(const f32x4*)(gate + (size_t)b * 6144 + c), pg = *(const f32x4*)(post_g + c);
            x[j] = x[j] + gt * (y[j] * rs * pg);
            *(f32x4*)(xout + (size_t)m * D + c) = x[j]; }
        if (NEXT == 1) {
            const float rs2 = rsqrtf(row_sumsq(x) * (1.f / D) + EPS);
#pragma unroll
            for (int j = 0; j < 4; ++j) { const int c = 4 * lane + 256 * j;
                const f32x4 gg = *(const f32x4*)(ng + c), s1 = *(const f32x4*)(scp + (size_t)b * 6144 + c), s0 = *(const f32x4*)(shp + (size_t)b * 6144 + c);
                const f32x4 h = x[j] * rs2 * gg * (1.f + s1) + s0;
                u32x2 o; o.x = pk2(h.x, h.y); o.y = pk2(h.z, h.w);
                *(u32x2*)(Hout + (size_t)m * D + c) = o; }
        }
    }
}
__device__ __forceinline__ void rowpass_t(const float* Y, const float* xin, float* xout, const float* gate, const float* post_g,
                                          const float* ng, const float* shp, const float* scp, bf16* HT, LAS unsigned char* lds, int tid, int lane, int wave, int G) {
    constexpr int PITCH = 1024 + 8;
    LAS bf16* tile = (LAS bf16*)lds;
    for (int it = blockIdx.x; it < ML / 64; it += G) {
        const int m0 = it * 64, b = m0 >> 11, t0 = m0 & 2047;
        __syncthreads();
        for (int rr = 0; rr < 8; ++rr) {
            const int r = wave * 8 + rr, m = m0 + r;
            f32x4 y[4], x[4]; load_row_f32(Y + (size_t)m * D, lane, y); load_row_f32(xin + (size_t)m * D, lane, x);
            const float rs = rsqrtf(row_sumsq(y) * (1.f / D) + EPS);
#pragma unroll
            for (int j = 0; j < 4; ++j) { const int c = 4 * lane + 256 * j;
                const f32x4 gt = *(const f32x4*)(gate + (size_t)b * 6144 + c), pg = *(const f32x4*)(post_g + c);
                x[j] = x[j] + gt * (y[j] * rs * pg);
                *(f32x4*)(xout + (size_t)m * D + c) = x[j]; }
            const float rs2 = rsqrtf(row_sumsq(x) * (1.f / D) + EPS);
#pragma unroll
            for (int j = 0; j < 4; ++j) { const int c = 4 * lane + 256 * j;
                const f32x4 gg = *(const f32x4*)(ng + c), s1 = *(const f32x4*)(scp + (size_t)b * 6144 + c), s0 = *(const f32x4*)(shp + (size_t)b * 6144 + c);
                const f32x4 h = x[j] * rs2 * gg * (1.f + s1) + s0;
                u32x2 o; o.x = pk2(h.x, h.y); o.y = pk2(h.z, h.w);
                *(LAS u32x2*)(tile + r * PITCH + c) = o; }
        }
        __syncthreads();
        unsigned lo[32], hi[32];
#pragma unroll
        for (int t = 0; t < 64; t += 2) {
            const unsigned w0 = *(const LAS unsigned*)(tile + t * PITCH + 2 * tid), w1 = *(const LAS unsigned*)(tile + (t + 1) * PITCH + 2 * tid);
            lo[t >> 1] = (w0 & 0xffffu) | (w1 << 16); hi[t >> 1] = (w0 >> 16) | (w1 & 0xffff0000u); }
        bf16* d0 = HT + ((size_t)b * D + 2 * tid) * T + t0; bf16* d1 = d0 + T;
#pragma unroll
        for (int q = 0; q < 8; ++q) { *(u32x4*)(d0 + 8 * q) = (u32x4){lo[4 * q], lo[4 * q + 1], lo[4 * q + 2], lo[4 * q + 3]};
                                      *(u32x4*)(d1 + 8 * q) = (u32x4){hi[4 * q], hi[4 * q + 1], hi[4 * q + 2], hi[4 * q + 3]}; }
    }
}

__device__ __forceinline__ void ngemm_tile(const bf16* A, int lda, const bf16* Bt, int ldb, int K, LAS float* sA, LAS float* sB, int tid, float (&acc)[4][4]) {
#pragma unroll
    for (int i = 0; i < 4; ++i)
#pragma unroll
        for (int j = 0; j < 4; ++j) acc[i][j] = 0.f;
    const int ty = tid >> 4, tx = tid & 15;
    for (int k0 = 0; k0 < K; k0 += 32) {
        { const u32x4 v = *(const u32x4*)(A + (size_t)(tid >> 2) * lda + k0 + (tid & 3) * 8);
          LAS float* d = sA + (tid >> 2) * 33 + (tid & 3) * 8;
          d[0] = bf2f(v.x & 0xffffu); d[1] = bf2f(v.x >> 16); d[2] = bf2f(v.y & 0xffffu); d[3] = bf2f(v.y >> 16);
          d[4] = bf2f(v.z & 0xffffu); d[5] = bf2f(v.z >> 16); d[6] = bf2f(v.w & 0xffffu); d[7] = bf2f(v.w >> 16); }
        { const u32x2 v = *(const u32x2*)(Bt + (size_t)(tid >> 3) * ldb + k0 + (tid & 7) * 4);
          LAS float* d = sB + (tid >> 3) * 33 + (tid & 7) * 4;
          d[0] = bf2f(v.x & 0xffffu); d[1] = bf2f(v.x >> 16); d[2] = bf2f(v.y & 0xffffu); d[3] = bf2f(v.y >> 16); }
        __syncthreads();
#pragma unroll 8
        for (int k = 0; k < 32; ++k) {
            float av[4], bv[4];
#pragma unroll
            for (int i = 0; i < 4; ++i) { av[i] = sA[(4 * ty + i) * 33 + k]; bv[i] = sB[(4 * tx + i) * 33 + k]; }
#pragma unroll
            for (int i = 0; i < 4; ++i)
#pragma unroll
                for (int j = 0; j < 4; ++j) acc[i][j] += av[i] * bv[j];
        }
        __syncthreads();
    }
}

__device__ __forceinline__ void p2_inproj_simple(const Args& a, LAS unsigned char* lds, int tid, int G) {
    LAS float* sA = (LAS float*)lds; LAS float* sB = sA + 128 * 33;
    const bf16* A = (const bf16*)(a.ws + WS_A); const bf16* W = (const bf16*)(a.ws + WS_WIN);
    bf16* Q = (bf16*)(a.ws + WS_Q); bf16* Kb = (bf16*)(a.ws + WS_K); bf16* V = (bf16*)(a.ws + WS_V); bf16* O = (bf16*)(a.ws + WS_O); float* Gt = (float*)(a.ws + WS_G);
    const float* bias = a.in[15];
    constexpr int NCB = 49;
    const int ty = tid >> 4, tx = tid & 15;
    for (int it = blockIdx.x; it < (MALL / 128) * NCB; it += G) {
        const int rt = it / NCB, cb = it % NCB, row0 = rt * 128, col0 = cb * 64;
        float acc[4][4];
        ngemm_tile(A + (size_t)row0 * D, D, W + (size_t)col0 * D, D, D, sA, sB, tid, acc);
#pragma unroll
        for (int i = 0; i < 4; ++i)
#pragma unroll
            for (int j = 0; j < 4; ++j) {
                const int r = row0 + 4 * ty + i, c = col0 + 4 * tx + j;
                if (c >= NPROJ) continue;
                const float v = acc[i][j] + bias[c];
                if (c < 512) { if (r < ML) Q[(size_t)r * 512 + c] = (bf16)f2bf(v); }
                else if (c < 1024) Kb[(size_t)r * 512 + (c - 512)] = (bf16)f2bf(v * 0.08838834764831845f);
                else if (c < 2048) V[(size_t)r * D + (c - 1024)] = (bf16)f2bf(v);
                else if (c < 3072) { if (r < ML) O[(size_t)r * D + (c - 2048)] = (bf16)f2bf(v); }
                else Gt[(size_t)r * 16 + (c - 3072)] = v;
            }
    }
}

__device__ __forceinline__ void gemm_simple_f32(const bf16* A, int lda, const bf16* Bt, int ldb, int M, int N, int K, float* C, int ldc, const float* bias, LAS unsigned char* lds, int tid, int G) {
    LAS float* sA = (LAS float*)lds; LAS float* sB = sA + 128 * 33;
    const int ty = tid >> 4, tx = tid & 15, ncb = N / 64;
    for (int it = blockIdx.x; it < (M / 128) * ncb; it += G) {
        const int rt = it / ncb, cb = it % ncb, row0 = rt * 128, col0 = cb * 64;
        float acc[4][4];
        ngemm_tile(A + (size_t)row0 * lda, lda, Bt + (size_t)col0 * ldb, ldb, K, sA, sB, tid, acc);
#pragma unroll
        for (int i = 0; i < 4; ++i) { f32x4 o = {acc[i][0], acc[i][1], acc[i][2], acc[i][3]};
            if (bias) o = o + *(const f32x4*)(bias + col0 + 4 * tx);
            *(f32x4*)(C + (size_t)(row0 + 4 * ty + i) * ldc + col0 + 4 * tx) = o; }
    }
}

__device__ __forceinline__ void p7_up_simple(const bf16* A, const bf16* W  , const float* cw  , const float* cb, bf16* ACT, LAS unsigned char* lds, int tid, int G) {
    LAS float* sA = (LAS float*)lds; LAS float* sB = sA + 128 * 33; LAS float* gs = sB + 64 * 33;
    const int ty = tid >> 4, tx = tid & 15;
    constexpr int NCB = FF / 64;
    for (int it = blockIdx.x; it < (ML / 128) * NCB; it += G) {
        const int rt = it / NCB, jb = it % NCB, row0 = rt * 128, j0 = jb * 64;
        const int wrow = (jb >> 1) * 256 + (jb & 1) * 64;
        float u[4][4], g[4][4];
        ngemm_tile(A + (size_t)row0 * D, D, W + (size_t)wrow * D, D, D, sA, sB, tid, u);
        ngemm_tile(A + (size_t)row0 * D, D, W + (size_t)(wrow + 128) * D, D, D, sA, sB, tid, g);
#pragma unroll
        for (int i = 0; i < 4; ++i)
#pragma unroll
            for (int j = 0; j < 4; ++j) gs[(4 * ty + i) * 65 + 4 * tx + j] = g[i][j];
        __syncthreads();
#pragma unroll
        for (int i = 0; i < 4; ++i)
#pragma unroll
            for (int j = 0; j < 4; ++j) {
                const int rl = 4 * ty + i, cl = 4 * tx + j, f = j0 + cl;
                const float gm = (rl & 63) ? gs[(rl - 1) * 65 + cl] : 0.f, gp = ((rl & 63) != 63) ? gs[(rl + 1) * 65 + cl] : 0.f;
                const float gc = gm * cw[f] + g[i][j] * cw[FF + f] + gp * cw[2 * FF + f] + cb[f];
                ACT[(size_t)(row0 + rl) * FF + f] = (bf16)f2bf(silu_f(gc) * u[i][j]);
            }
        __syncthreads();
    }
}

__device__ __forceinline__ void p10_seqmix_simple(const Args& a, LAS unsigned char* lds, int tid, int G) {
    LAS float* sA = (LAS float*)lds; LAS float* sB = sA + 128 * 33;
    const bf16* DF = (const bf16*)(a.ws + WS_DFT); const bf16* HT = (const bf16*)(a.ws + WS_HT); bf16* PQ = (bf16*)(a.ws + WS_PQ);
    const int ty = tid >> 4, tx = tid & 15;
    for (int it = blockIdx.x; it < 8 * 32 * 16; it += G) {
        const int b = it >> 9, rt = (it >> 4) & 31, cbk = it & 15, r0 = rt * 128, c0 = cbk * 64;
        float acc[4][4];
        ngemm_tile(DF + (size_t)r0 * 2048, 2048, HT + ((size_t)b * D + c0) * T, T, 2048, sA, sB, tid, acc);
        const int kind = r0 >> 11, tp0 = r0 & 2047;
#pragma unroll
        for (int i = 0; i < 4; ++i) { u32x2 o; o.x = pk2(acc[i][0], acc[i][1]); o.y = pk2(acc[i][2], acc[i][3]);
            *(u32x2*)(PQ + (size_t)(b * 2048 + tp0 + 4 * ty + i) * 2048 + kind * 1024 + c0 + 4 * tx) = o; }
    }
}

__device__ __forceinline__ void p3_mlstm_simple(const Args& a, LAS unsigned char* lds, int tid, int G) {
    const bf16* Q = (const bf16*)(a.ws + WS_Q); const bf16* Kb = (const bf16*)(a.ws + WS_K); const bf16* V = (const bf16*)(a.ws + WS_V); const float* Gt = (const float*)(a.ws + WS_G);
    LAS float* sq = (LAS float*)lds;
    LAS float* sk = sq + 64 * 128;
    LAS float* sv = sk + 64 * 128;
    LAS float* sg = sv + 64 * 32;
    const int j = tid >> 4, g = tid & 15;
    for (int it = blockIdx.x; it < 64 * 8; it += G) {
        const int bh = it >> 4, dir = (it >> 3) & 1, dvb = it & 7, b = bh >> 2, h = bh & 3;
        bf16* Hout = (bf16*)(a.ws + (dir ? WS_HB : WS_HF));
        float Cst[8], nst[8];
#pragma unroll
        for (int d = 0; d < 8; ++d) { Cst[d] = 0.f; nst[d] = 0.f; }
        for (int sb = 0; sb < 36; ++sb) {
            const bool isctx = sb < 4;
            const int nblk = isctx ? 4 : 32, bi = isctx ? sb : sb - 4;
            const int blk = dir ? (nblk - 1 - bi) : bi;
            const int rowbase = isctx ? (ML + b * TC + blk * 64) : (b * T + blk * 64);
            __syncthreads();
            for (int i = tid; i < 64 * 128; i += NTHR) { const int p = i >> 7, c = i & 127; const int tok = rowbase + (dir ? 63 - p : p);
                sk[i] = bf2f(Kb[(size_t)tok * 512 + h * 128 + c]);
                sq[i] = isctx ? 0.f : bf2f(Q[(size_t)tok * 512 + h * 128 + c]); }
            for (int i = tid; i < 64 * 32; i += NTHR) { const int p = i >> 5, c = i & 31; const int tok = rowbase + (dir ? 63 - p : p);
                sv[i] = bf2f(V[(size_t)tok * D + h * 256 + dvb * 32 + c]); }
            if (tid < 64) { const int tok = rowbase + (dir ? 63 - tid : tid);
                sg[2 * tid] = __expf(Gt[(size_t)tok * 16 + dir * 8 + h]); sg[2 * tid + 1] = __expf(logsigmoid_f(Gt[(size_t)tok * 16 + dir * 8 + 4 + h])); }
            __syncthreads();
            for (int p = 0; p < 64; ++p) {
                const float iv = sg[2 * p], fv = sg[2 * p + 1], vv = sv[p * 32 + j];
                float pn = 0.f, pd = 0.f;
#pragma unroll
                for (int d = 0; d < 8; ++d) { const float kk = sk[p * 128 + 8 * g + d], qq = sq[p * 128 + 8 * g + d];
                    Cst[d] = fv * Cst[d] + iv * kk * vv; nst[d] = fv * nst[d] + iv * kk;
                    pn += qq * Cst[d]; pd += qq * nst[d]; }
                if (!isctx) {
                    pn += __shfl_xor(pn, 1); pn += __shfl_xor(pn, 2); pn += __shfl_xor(pn, 4); pn += __shfl_xor(pn, 8);
                    pd += __shfl_xor(pd, 1); pd += __shfl_xor(pd, 2); pd += __shfl_xor(pd, 4); pd += __shfl_xor(pd, 8);
                    if (g == 0) { const int tok = rowbase + (dir ? 63 - p : p);
                        Hout[(size_t)tok * D + h * 256 + dvb * 32 + j] = (bf16)f2bf(pn / fmaxf(fabsf(pd), 1.0f)); }
                }
            }
        }
    }
}

__global__ void __launch_bounds__(NTHR, 2) mk_fwd(Args a) {
    extern __shared__ __attribute__((aligned(16))) unsigned char lds_raw[];
    LAS unsigned char* lds = (LAS unsigned char*)lds_raw;
    const int tid = threadIdx.x, lane = tid & 63, wave = __builtin_amdgcn_readfirstlane(tid >> 6), G = gridDim.x;
    const int lo = a.ph_lo, hi = a.ph_hi;
    unsigned char* ws = a.ws;
    const float* MOD0 = (const float*)(ws + WS_MOD); const float* MOD1 = MOD0 + 9 * 6144;
#define IN(k) (lo <= (k) && (k) < hi)
#define SEAM(k) do { if (IN(k) && IN((k) + 1)) { __threadfence(); cg::this_grid().sync(); } } while (0)

    if (IN(0)) { p0_prep(a, lds, tid, lane, wave, G); } SEAM(0);
    if (IN(1)) { p1_norm_mod(a, lane, wave, G); } SEAM(1);
    if (IN(2)) { p2_inproj_simple(a, lds, tid, G); } SEAM(2);
    if (IN(3)) { p3_mlstm_simple(a, lds, tid, G); } SEAM(3);
    if (IN(4)) { p4_readout(a, lane, wave, G); } SEAM(4);
    if (IN(5)) { gemm_simple_f32((const bf16*)(ws + WS_Y), D, (const bf16*)(ws + WS_WOUT), D, ML, D, D, (float*)(ws + WS_Y1), D, nullptr, lds, tid, G); } SEAM(5);
    if (IN(6)) { rowpass<1>((const float*)(ws + WS_Y1), a.in[0], a.out, MOD0 + 2 * D, a.in[7], a.in[8], MOD0 + 3 * D, MOD0 + 4 * D, (bf16*)(ws + WS_H2), lane, wave, G); } SEAM(6);
    if (IN(7)) { p7_up_simple((const bf16*)(ws + WS_H2), (const bf16*)(ws + WS_WUP), a.in[11], a.in[12], (bf16*)(ws + WS_ACT), lds, tid, G); } SEAM(7);
    if (IN(8)) { gemm_simple_f32((const bf16*)(ws + WS_ACT), FF, (const bf16*)(ws + WS_WDN), FF, ML, D, FF, (float*)(ws + WS_Y2), D, nullptr, lds, tid, G); } SEAM(8);
    if (IN(9)) { rowpass_t((const float*)(ws + WS_Y2), a.out, a.out, MOD0 + 5 * D, a.in[9], a.in[6] + D, MOD1, MOD1 + D, (bf16*)(ws + WS_HT), lds, tid, lane, wave, G); } SEAM(9);
    if (IN(10)) { p10_seqmix_simple(a, lds, tid, G); } SEAM(10);
    if (IN(11)) { gemm_simple_f32((const bf16*)(ws + WS_PQ), 2048, (const bf16*)(ws + WS_WCS), 2048, ML, D, 2048, (float*)(ws + WS_Y3), D, a.in[19], lds, tid, G); } SEAM(11);
    if (IN(12)) { rowpass<1>((const float*)(ws + WS_Y3), a.out, a.out, MOD1 + 2 * D, a.in[7] + D, a.in[8] + D, MOD1 + 3 * D, MOD1 + 4 * D, (bf16*)(ws + WS_H2B), lane, wave, G); } SEAM(12);
    if (IN(13)) { p7_up_simple((const bf16*)(ws + WS_H2B), (const bf16*)(ws + WS_WUP) + (size_t)NUP * D, a.in[11] + 3 * FF, a.in[12] + FF, (bf16*)(ws + WS_ACT1), lds, tid, G); } SEAM(13);
    if (IN(14)) { gemm_simple_f32((const bf16*)(ws + WS_ACT1), FF, (const bf16*)(ws + WS_WDN) + (size_t)D * FF, FF, ML, D, FF, (float*)(ws + WS_Y2B), D, nullptr, lds, tid, G); } SEAM(14);
    if (IN(15)) { rowpass<0>((const float*)(ws + WS_Y2B), a.out, a.out, MOD1 + 5 * D, a.in[9] + D, nullptr, nullptr, nullptr, nullptr, lane, wave, G); }
#undef IN
#undef SEAM
}

extern "C" void kernel_launch(void* const* d_in, const int* in_sizes, int n_in, void* d_out, int out_size, void* d_ws, size_t ws_size, hipStream_t stream) {
    static int grid = 0;
    if (grid == 0) {
        if (n_in != 20 || out_size != ML * D || ws_size < WS_END) { fprintf(stderr, "kernel_launch: unexpected shapes (n_in %d out %d ws %zu)\n", n_in, out_size, ws_size); grid = -1; return; }
        int dev = 0, cus = 0, per_cu = 0;
        (void)hipGetDevice(&dev); (void)hipDeviceGetAttribute(&cus, hipDeviceAttributeMultiprocessorCount, dev);
        (void)hipFuncSetAttribute((const void*)mk_fwd, hipFuncAttributeMaxDynamicSharedMemorySize, LDS_BYTES);
        (void)hipOccupancyMaxActiveBlocksPerMultiprocessor(&per_cu, (const void*)mk_fwd, NTHR, LDS_BYTES);
        if (per_cu < 1) { fprintf(stderr, "kernel_launch: occupancy query says %d blocks/CU\n", per_cu); per_cu = 1; }
        grid = cus * 1;
        (void)hipGetLastError();
    }
    if (grid < 0) return;
    (void)hipMemsetAsync((char*)d_ws + WS_CTL, 0, 1 * MiB, stream);
    Args a{};
    for (int i = 0; i < 20; ++i) a.in[i] = (const float*)d_in[i];
    a.out = (float*)d_out; a.ws = (unsigned char*)d_ws;
    if (MK_N_LAUNCHES == 1) {
        a.ph_lo = 0; a.ph_hi = NPH;
        void* args[] = {&a};
        hipError_t e = hipLaunchCooperativeKernel((const void*)mk_fwd, dim3(grid), dim3(NTHR), args, LDS_BYTES, stream);
        if (e != hipSuccess) fprintf(stderr, "cooperative launch failed: %s (grid %d)\n", hipGetErrorString(e), grid);
    } else {
        for (int p = 0; p < NPH; ++p) { a.ph_lo = p; a.ph_hi = p + 1;
            hipLaunchKernelGGL(mk_fwd, dim3(grid), dim3(NTHR), LDS_BYTES, stream, a); }
    }
}
```

```cpp
#include <hip/hip_runtime.h>
#include <hip/hip_cooperative_groups.h>
#include <cstdio>
#include <cstdint>
namespace cg = cooperative_groups;

#ifndef MK_N_LAUNCHES
#define MK_N_LAUNCHES 1
#endif

#define GAS __attribute__((address_space(1)))
#define LAS __attribute__((address_space(3)))
typedef unsigned short bf16;
typedef float f32x4 __attribute__((ext_vector_type(4)));
typedef unsigned u32x4 __attribute__((ext_vector_type(4)));
typedef unsigned u32x2 __attribute__((ext_vector_type(2)));

constexpr int D = 1024, NB = 8, T = 2048, TC = 256;
constexpr int ML = NB * T;
constexpr int MC = NB * TC;
constexpr int MALL = ML + MC;
constexpr int NH = 4, DK = 128, DV = 256;
constexpr int NPROJ = 3088, NPROJ_PAD = 3328;
constexpr int FF = 2816, NUP = 2 * FF;
constexpr float EPS = 1e-6f;
constexpr int NPH = 16;
constexpr int NWAVES = 8, NTHR = 512;

constexpr size_t MiB = 1u << 20;
constexpr size_t WS_CTL = 0;
constexpr size_t WS_MOD = 1 * MiB;
constexpr size_t WS_WIN = 2 * MiB;
constexpr size_t WS_WOUT = WS_WIN + (size_t)NPROJ_PAD * D * 2;
constexpr size_t WS_WUP = WS_WOUT + (size_t)D * D * 2;
constexpr size_t WS_WDN = WS_WUP + (size_t)2 * NUP * D * 2;
constexpr size_t WS_WCS = WS_WDN + (size_t)2 * D * FF * 2;
constexpr size_t WS_DFT = WS_WCS + (size_t)D * 2048 * 2;
constexpr size_t WS_A = WS_DFT + (size_t)4096 * 2048 * 2;
constexpr size_t WS_C = WS_A + (size_t)MALL * D * 2;
constexpr size_t WS_B = WS_C + (size_t)ML * D * 2;
constexpr size_t WS_Q = WS_B;
constexpr size_t WS_K = WS_Q + (size_t)ML * 512 * 2;
constexpr size_t WS_V = WS_K + (size_t)MALL * 512 * 2;
constexpr size_t WS_O = WS_V + (size_t)MALL * D * 2;
constexpr size_t WS_G = WS_O + (size_t)ML * D * 2;
constexpr size_t WS_END = WS_B + 104 * MiB;
static_assert(WS_G + (size_t)MALL * 16 * 4 <= WS_END, "region B");
static_assert(WS_END <= 256 * MiB, "workspace");
constexpr size_t WS_HF = WS_A;
constexpr size_t WS_HB = WS_C;
constexpr size_t WS_Y = WS_Q;
constexpr size_t WS_Y1 = WS_V;
constexpr size_t WS_H2 = WS_A;
constexpr size_t WS_ACT = WS_B;
constexpr size_t WS_Y2 = WS_A;
constexpr size_t WS_HT = WS_B;
constexpr size_t WS_PQ = WS_B + 32 * MiB;
constexpr size_t WS_Y3 = WS_A;
constexpr size_t WS_H2B = WS_B + 72 * MiB;
constexpr size_t WS_ACT1 = WS_A;
constexpr size_t WS_Y2B = WS_B + 24 * MiB;
static_assert(WS_V + (size_t)ML * D * 4 <= WS_G, "y1 overlay");
static_assert(WS_ACT1 + (size_t)ML * FF * 2 <= WS_H2B && WS_ACT1 + (size_t)ML * FF * 2 <= WS_Y2B, "layer-1 overlays");
static_assert(WS_Y2B + (size_t)ML * D * 4 <= WS_END && WS_H2B + (size_t)ML * D * 2 <= WS_END && WS_PQ + (size_t)ML * 2048 * 2 <= WS_END, "layer-1 overlays");

constexpr int LDS_BYTES = 147456;

__device__ __forceinline__ float bf2f(unsigned v) { return __uint_as_float(v << 16); }
__device__ __forceinline__ unsigned f2bf(float f) { unsigned u = __float_as_uint(f); return (u + 0x7fffu + ((u >> 16) & 1u)) >> 16; }
__device__ __forceinline__ unsigned pk2(float lo, float hi) { return f2bf(lo) | (f2bf(hi) << 16); }
__device__ __forceinline__ float silu_f(float v) { return v / (1.f + __expf(-v)); }
__device__ __forceinline__ float sigmoid_f(float v) { return 1.f / (1.f + __expf(-v)); }
__device__ __forceinline__ float logsigmoid_f(float v) { return fminf(v, 0.f) - log1pf(__expf(-fabsf(v))); }
__device__ __forceinline__ float wave_sum(float v) {
#pragma unroll
    for (int o = 1; o < 64; o <<= 1) v += __shfl_xor(v, o);
    return v;
}

struct Args { const float* in[20]; float* out; unsigned char* ws; int ph_lo, ph_hi; };

template <int MODE>
__device__ __forceinline__ void p0_transpose_item(const float* W, int K, int N, bf16* WT, LAS float* scr, int item, int nblk, int lane) {
    const int kb = item / nblk, nb = item % nblk, k0 = 64 * kb, n0 = 32 * nb;
#pragma unroll 8
    for (int i = 0; i < 32; ++i) { const int kk = 2 * i + (lane >> 5); const int n = n0 + (lane & 31);
        scr[kk * 33 + (lane & 31)] = (n < N) ? W[(size_t)(k0 + kk) * N + n] : 0.f; }
    asm volatile("s_waitcnt lgkmcnt(0)" ::: "memory");
    const int c = lane & 7;
#pragma unroll
    for (int j = 0; j < 4; ++j) { const int nl = (lane >> 3) + 8 * j; const LAS float* s = scr + (8 * c) * 33 + nl;
        u32x4 o; o.x = pk2(s[0 * 33], s[1 * 33]); o.y = pk2(s[2 * 33], s[3 * 33]); o.z = pk2(s[4 * 33], s[5 * 33]); o.w = pk2(s[6 * 33], s[7 * 33]);
        int n = n0 + nl, dr = n;
        if (MODE == 1) { const int isg = n >= FF ? 1 : 0; const int jj = n - isg * FF; dr = (jj >> 7) * 256 + isg * 128 + (jj & 127); }
        *(u32x4*)(WT + (size_t)dr * K + k0 + 8 * c) = o; }
    asm volatile("s_waitcnt lgkmcnt(0)" ::: "memory");
}

__device__ __forceinline__ void p0_prep(const Args& a, LAS unsigned char* lds, int tid, int lane, int wave, int G) {
    unsigned char* ws = a.ws;
    {
        LAS float* scr = (LAS float*)(lds + wave * 16384);
        const int gw = blockIdx.x * NWAVES + wave, NGW = G * NWAVES;
        constexpr int I_IN = 16 * (NPROJ_PAD / 32), I_OUT = 16 * 32, I_UP = 16 * (NUP / 32), I_DN = (FF / 64) * 32;
        constexpr int NIT = I_IN + I_OUT + 2 * I_UP + 2 * I_DN;
        for (int it = gw; it < NIT; it += NGW) {
            int r = it;
            if (r < I_IN) { p0_transpose_item<0>(a.in[14], D, NPROJ, (bf16*)(ws + WS_WIN), scr, r, NPROJ_PAD / 32, lane); continue; } r -= I_IN;
            if (r < I_OUT) { p0_transpose_item<0>(a.in[17], D, D, (bf16*)(ws + WS_WOUT), scr, r, 32, lane); continue; } r -= I_OUT;
            if (r < I_UP) { p0_transpose_item<1>(a.in[10], D, NUP, (bf16*)(ws + WS_WUP), scr, r, NUP / 32, lane); continue; } r -= I_UP;
            if (r < I_UP) { p0_transpose_item<1>(a.in[10] + (size_t)D * NUP, D, NUP, (bf16*)(ws + WS_WUP) + (size_t)NUP * D, scr, r, NUP / 32, lane); continue; } r -= I_UP;
            if (r < I_DN) { p0_transpose_item<0>(a.in[13], FF, D, (bf16*)(ws + WS_WDN), scr, r, 32, lane); continue; } r -= I_DN;
            p0_transpose_item<0>(a.in[13] + (size_t)FF * D, FF, D, (bf16*)(ws + WS_WDN) + (size_t)D * FF, scr, r, 32, lane);
        }
    }
    __syncthreads();
    LAS float* tab = (LAS float*)(lds + 131072);
    for (int i = tid; i < 2048; i += NTHR) tab[i] = cospif((float)i * (1.0f / 1024.0f));
    __syncthreads();
    {
        bf16* DF = (bf16*)(ws + WS_DFT);
        const int total = 4096 * 256;
        for (int idx = blockIdx.x * NTHR + tid; idx < total; idx += G * NTHR) {
            const int r = idx >> 8, t0 = (idx & 255) * 8, tp = r & 2047, sh = (r >> 11) ? 512 : 0;
            float v[8];
#pragma unroll
            for (int j = 0; j < 8; ++j) v[j] = tab[(tp * (t0 + j) + sh) & 2047] * (1.0f / 512.0f);
            u32x4 o; o.x = pk2(v[0], v[1]); o.y = pk2(v[2], v[3]); o.z = pk2(v[4], v[5]); o.w = pk2(v[6], v[7]);
            *(u32x4*)(DF + (size_t)r * 2048 + t0) = o;
        }
    }
    {
        const float* W = a.in[18]; bf16* WCS = (bf16*)(ws + WS_WCS);
        LAS float* wt = (LAS float*)lds;
        for (int it = blockIdx.x; it < 8 * 16; it += G) {
            const int g = it >> 4, n0 = (it & 15) * 64;
            __syncthreads();
            for (int i = tid; i < 128 * 64; i += NTHR) wt[i] = W[(size_t)(g * 128 + (i >> 6)) * D + n0 + (i & 63)];
            __syncthreads();
            const int nl = tid >> 3, cgp = tid & 7;
            float ac[16], as[16];
#pragma unroll
            for (int j = 0; j < 16; ++j) { ac[j] = 0.f; as[j] = 0.f; }
            for (int cp = 0; cp < 128; ++cp) {
                const float w = wt[cp * 64 + nl];
#pragma unroll
                for (int j = 0; j < 16; ++j) { const int c = 16 * cgp + j; const int ph = (c * cp) & 127;
                    ac[j] += tab[ph * 16] * w; as[j] += tab[((ph * 16) + 1536) & 2047] * w; }
            }
            bf16* dst = WCS + (size_t)(n0 + nl) * 2048 + g * 128 + 16 * cgp;
            u32x4 o0, o1;
            o0.x = pk2(ac[0], ac[1]); o0.y = pk2(ac[2], ac[3]); o0.z = pk2(ac[4], ac[5]); o0.w = pk2(ac[6], ac[7]);
            o1.x = pk2(ac[8], ac[9]); o1.y = pk2(ac[10], ac[11]); o1.z = pk2(ac[12], ac[13]); o1.w = pk2(ac[14], ac[15]);
            *(u32x4*)dst = o0; *(u32x4*)(dst + 8) = o1;
            o0.x = pk2(as[0], as[1]); o0.y = pk2(as[2], as[3]); o0.z = pk2(as[4], as[5]); o0.w = pk2(as[6], as[7]);
            o1.x = pk2(as[8], as[9]); o1.y = pk2(as[10], as[11]); o1.z = pk2(as[12], as[13]); o1.w = pk2(as[14], as[15]);
            *(u32x4*)(dst + 1024) = o0; *(u32x4*)(dst + 1024 + 8) = o1;
        }
    }
    __syncthreads();
    {
        LAS float* sc = (LAS float*)lds;
        LAS float* red = (LAS float*)(lds + 40960);
        for (int i = tid; i < 9 * 1024; i += NTHR) { const float v = (i < 8 * 1024) ? a.in[1][i] : a.in[3][i - 8 * 1024]; sc[i] = silu_f(v); }
        __syncthreads();
        float* MOD = (float*)(ws + WS_MOD);
        for (int it = blockIdx.x; it < 2 * 96; it += G) {
            const int l = it / 96, c0 = (it % 96) * 64;
            const float* Wl = a.in[4] + (size_t)l * D * 6144 + c0 + lane;
            float acc[9];
#pragma unroll
            for (int r = 0; r < 9; ++r) acc[r] = 0.f;
            const int kb = wave * 128;
#pragma unroll 4
            for (int k = 0; k < 128; ++k) { const float w = Wl[(size_t)(kb + k) * 6144];
#pragma unroll
                for (int r = 0; r < 9; ++r) acc[r] += sc[r * 1024 + kb + k] * w; }
#pragma unroll
            for (int r = 0; r < 9; ++r) red[(wave * 9 + r) * 64 + lane] = acc[r];
            __syncthreads();
            for (int i = tid; i < 9 * 64; i += NTHR) { float s = 0.f;
#pragma unroll
                for (int w = 0; w < 8; ++w) s += red[w * 576 + i];
                const int r = i >> 6, cl = i & 63;
                MOD[((size_t)l * 9 + r) * 6144 + c0 + cl] = s + a.in[5][(size_t)l * 6144 + c0 + cl]; }
            __syncthreads();
        }
    }
}

__device__ __forceinline__ void load_row_f32(const float* p, int lane, f32x4 (&v)[4]) {
#pragma unroll
    for (int j = 0; j < 4; ++j) v[j] = *(const f32x4*)(p + 4 * lane + 256 * j);
}
__device__ __forceinline__ float row_sumsq(const f32x4 (&v)[4]) {
    float s = 0.f;
#pragma unroll
    for (int j = 0; j < 4; ++j) s += (v[j].x * v[j].x + v[j].y * v[j].y) + (v[j].z * v[j].z + v[j].w * v[j].w);
    return wave_sum(s);
}

__device__ __forceinline__ void p1_norm_mod(const Args& a, int lane, int wave, int G) {
    const float* MOD = (const float*)(a.ws + WS_MOD);
    bf16* A = (bf16*)(a.ws + WS_A);
    const float* g = a.in[6];
    const int gw = blockIdx.x * NWAVES + wave, NGW = G * NWAVES;
    for (int m = gw; m < MALL; m += NGW) {
        const float* xr = (m < ML) ? a.in[0] + (size_t)m * D : a.in[2] + (size_t)(m - ML) * D;
        const int mr = (m < ML) ? (m >> 11) : 8;
        const float* sh = MOD + (size_t)mr * 6144, * sc = sh + D;
        f32x4 v[4]; load_row_f32(xr, lane, v);
        const float rs = rsqrtf(row_sumsq(v) * (1.f / D) + EPS);
#pragma unroll
        for (int j = 0; j < 4; ++j) { const int c = 4 * lane + 256 * j;
            const f32x4 gg = *(const f32x4*)(g + c), s1 = *(const f32x4*)(sc + c), s0 = *(const f32x4*)(sh + c);
            const f32x4 h = v[j] * rs * gg * (1.f + s1) + s0;
            u32x2 o; o.x = pk2(h.x, h.y); o.y = pk2(h.z, h.w);
            *(u32x2*)(A + (size_t)m * D + c) = o; }
    }
}

__device__ __forceinline__ void p4_readout(const Args& a, int lane, int wave, int G) {
    const bf16* HF = (const bf16*)(a.ws + WS_HF); const bf16* HB = (const bf16*)(a.ws + WS_HB); const bf16* O = (const bf16*)(a.ws + WS_O);
    bf16* Y = (bf16*)(a.ws + WS_Y); const float* ng = a.in[16];
    const int gw = blockIdx.x * NWAVES + wave, NGW = G * NWAVES;
    for (int m = gw; m < ML; m += NGW) {
        const size_t off = (size_t)m * D + 16 * lane;
        const u32x4 f0 = *(const u32x4*)(HF + off), f1 = *(const u32x4*)(HF + off + 8);
        const u32x4 b0 = *(const u32x4*)(HB + off), b1 = *(const u32x4*)(HB + off + 8);
        const u32x4 o0 = *(const u32x4*)(O + off), o1 = *(const u32x4*)(O + off + 8);
        float h[16], og[16];
        const unsigned fw[8] = {f0.x, f0.y, f0.z, f0.w, f1.x, f1.y, f1.z, f1.w};
        const unsigned bw[8] = {b0.x, b0.y, b0.z, b0.w, b1.x, b1.y, b1.z, b1.w};
        const unsigned ow[8] = {o0.x, o0.y, o0.z, o0.w, o1.x, o1.y, o1.z, o1.w};
        float ss = 0.f;
#pragma unroll
        for (int j = 0; j < 8; ++j) {
            h[2 * j] = bf2f(fw[j] & 0xffffu) + bf2f(bw[j] & 0xffffu); h[2 * j + 1] = bf2f(fw[j] >> 16) + bf2f(bw[j] >> 16);
            og[2 * j] = bf2f(ow[j] & 0xffffu); og[2 * j + 1] = bf2f(ow[j] >> 16);
            ss += h[2 * j] * h[2 * j] + h[2 * j + 1] * h[2 * j + 1]; }
        ss += __shfl_xor(ss, 1); ss += __shfl_xor(ss, 2); ss += __shfl_xor(ss, 4); ss += __shfl_xor(ss, 8);
        const float rs = rsqrtf(ss * (1.f / DV) + EPS);
        unsigned w[8];
#pragma unroll
        for (int j = 0; j < 8; ++j) {
            const float y0 = h[2 * j] * rs * ng[16 * lane + 2 * j] * sigmoid_f(og[2 * j]);
            const float y1 = h[2 * j + 1] * rs * ng[16 * lane + 2 * j + 1] * sigmoid_f(og[2 * j + 1]);
            w[j] = pk2(y0, y1); }
        *(u32x4*)(Y + off) = (u32x4){w[0], w[1], w[2], w[3]}; *(u32x4*)(Y + off + 8) = (u32x4){w[4], w[5], w[6], w[7]};
    }
}

template <int NEXT>
__device__ __forceinline__ void rowpass(const float* Y, const float* xin, float* xout, const float* gate  , const float* post_g,
                                        const float* ng, const float* shp, const float* scp, bf16* Hout, int lane, int wave, int G) {
    const int gw = blockIdx.x * NWAVES + wave, NGW = G * NWAVES;
    for (int m = gw; m < ML; m += NGW) {
        const int b = m >> 11;
        f32x4 y[4], x[4]; load_row_f32(Y + (size_t)m * D, lane, y); load_row_f32(xin + (size_t)m * D, lane, x);
        const float rs = rsqrtf(row_sumsq(y) * (1.f / D) + EPS);
#pragma unroll
        for (int j = 0; j < 4; ++j) { const int c = 4 * lane + 256 * j;
            const f32x4 gt = *(const f32x4*)(gate + (size_t)b * 6144 + c), pg = *(const f32x4*)(post_g + c);
            x[j] = x[j] + gt * (y[j] * rs * pg);
            *(f32x4*)(xout + (size_t)m * D + c) = x[j]; }
        if (NEXT == 1) {
            const float rs2 = rsqrtf(row_sumsq(x) * (1.f / D) + EPS);
#pragma unroll
            for (int j = 0; j < 4; ++j) { const int c = 4 * lane + 256 * j;
                const f32x4 gg = *(const f32x4*)(ng + c), s1 = *(const f32x4*)(scp + (size_t)b * 6144 + c), s0 = *(const f32x4*)(shp + (size_t)b * 6144 + c);
                const f32x4 h = x[j] * rs2 * gg * (1.f + s1) + s0;
                u32x2 o; o.x = pk2(h.x, h.y); o.y = pk2(h.z, h.w);
                *(u32x2*)(Hout + (size_t)m * D + c) = o; }
        }
    }
}
__device__ __forceinline__ void rowpass_t(const float* Y, const float* xin, float* xout, const float* gate, const float* post_g,
                                          const float* ng, const float* shp, const float* scp, bf16* HT, LAS unsigned char* lds, int tid, int lane, int wave, int G) {
    constexpr int PITCH = 1024 + 8;
    LAS bf16* tile = (LAS bf16*)lds;
    for (int it = blockIdx.x; it < ML / 64; it += G) {
        const int m0 = it * 64, b = m0 >> 11, t0 = m0 & 2047;
        __syncthreads();
        for (int rr = 0; rr < 8; ++rr) {
            const int r = wave * 8 + rr, m = m0 + r;
            f32x4 y[4], x[4]; load_row_f32(Y + (size_t)m * D, lane, y); load_row_f32(xin + (size_t)m * D, lane, x);
            const float rs = rsqrtf(row_sumsq(y) * (1.f / D) + EPS);
#pragma unroll
            for (int j = 0; j < 4; ++j) { const int c = 4 * lane + 256 * j;
                const f32x4 gt = *(const f32x4*)(gate + (size_t)b * 6144 + c), pg = *(const f32x4*)(post_g + c);
                x[j] = x[j] + gt * (y[j] * rs * pg);
                *(f32x4*)(xout + (size_t)m * D + c) = x[j]; }
            const float rs2 = rsqrtf(row_sumsq(x) * (1.f / D) + EPS);
#pragma unroll
            for (int j = 0; j < 4; ++j) { const int c = 4 * lane + 256 * j;
                const f32x4 gg = *(const f32x4*)(ng + c), s1 = *(const f32x4*)(scp + (size_t)b * 6144 + c), s0 = *(const f32x4*)(shp + (size_t)b * 6144 + c);
                const f32x4 h = x[j] * rs2 * gg * (1.f + s1) + s0;
                u32x2 o; o.x = pk2(h.x, h.y); o.y = pk2(h.z, h.w);
                *(LAS u32x2*)(tile + r * PITCH + c) = o; }
        }
        __syncthreads();
        unsigned lo[32], hi[32];
#pragma unroll
        for (int t = 0; t < 64; t += 2) {
            const unsigned w0 = *(const LAS unsigned*)(tile + t * PITCH + 2 * tid), w1 = *(const LAS unsigned*)(tile + (t + 1) * PITCH + 2 * tid);
            lo[t >> 1] = (w0 & 0xffffu) | (w1 << 16); hi[t >> 1] = (w0 >> 16) | (w1 & 0xffff0000u); }
        bf16* d0 = HT + ((size_t)b * D + 2 * tid) * T + t0; bf16* d1 = d0 + T;
#pragma unroll
        for (int q = 0; q < 8; ++q) { *(u32x4*)(d0 + 8 * q) = (u32x4){lo[4 * q], lo[4 * q + 1], lo[4 * q + 2], lo[4 * q + 3]};
                                      *(u32x4*)(d1 + 8 * q) = (u32x4){hi[4 * q], hi[4 * q + 1], hi[4 * q + 2], hi[4 * q + 3]}; }
    }
}

__device__ __forceinline__ void ngemm_tile(const bf16* A, int lda, const bf16* Bt, int ldb, int K, LAS float* sA, LAS float* sB, int tid, float (&acc)[4][4]) {
#pragma unroll
    for (int i = 0; i < 4; ++i)
#pragma unroll
        for (int j = 0; j < 4; ++j) acc[i][j] = 0.f;
    const int ty = tid >> 4, tx = tid & 15;
    for (int k0 = 0; k0 < K; k0 += 32) {
        { const u32x4 v = *(const u32x4*)(A + (size_t)(tid >> 2) * lda + k0 + (tid & 3) * 8);
          LAS float* d = sA + (tid >> 2) * 33 + (tid & 3) * 8;
          d[0] = bf2f(v.x & 0xffffu); d[1] = bf2f(v.x >> 16); d[2] = bf2f(v.y & 0xffffu); d[3] = bf2f(v.y >> 16);
          d[4] = bf2f(v.z & 0xffffu); d[5] = bf2f(v.z >> 16); d[6] = bf2f(v.w & 0xffffu); d[7] = bf2f(v.w >> 16); }
        { const u32x2 v = *(const u32x2*)(Bt + (size_t)(tid >> 3) * ldb + k0 + (tid & 7) * 4);
          LAS float* d = sB + (tid >> 3) * 33 + (tid & 7) * 4;
          d[0] = bf2f(v.x & 0xffffu); d[1] = bf2f(v.x >> 16); d[2] = bf2f(v.y & 0xffffu); d[3] = bf2f(v.y >> 16); }
        __syncthreads();
#pragma unroll 8
        for (int k = 0; k < 32; ++k) {
            float av[4], bv[4];
#pragma unroll
            for (int i = 0; i < 4; ++i) { av[i] = sA[(4 * ty + i) * 33 + k]; bv[i] = sB[(4 * tx + i) * 33 + k]; }
#pragma unroll
            for (int i = 0; i < 4; ++i)
#pragma unroll
                for (int j = 0; j < 4; ++j) acc[i][j] += av[i] * bv[j];
        }
        __syncthreads();
    }
}

__device__ __forceinline__ void p2_inproj_simple(const Args& a, LAS unsigned char* lds, int tid, int G) {
    LAS float* sA = (LAS float*)lds; LAS float* sB = sA + 128 * 33;
    const bf16* A = (const bf16*)(a.ws + WS_A); const bf16* W = (const bf16*)(a.ws + WS_WIN);
    bf16* Q = (bf16*)(a.ws + WS_Q); bf16* Kb = (bf16*)(a.ws + WS_K); bf16* V = (bf16*)(a.ws + WS_V); bf16* O = (bf16*)(a.ws + WS_O); float* Gt = (float*)(a.ws + WS_G);
    const float* bias = a.in[15];
    constexpr int NCB = 49;
    const int ty = tid >> 4, tx = tid & 15;
    for (int it = blockIdx.x; it < (MALL / 128) * NCB; it += G) {
        const int rt = it / NCB, cb = it % NCB, row0 = rt * 128, col0 = cb * 64;
        float acc[4][4];
        ngemm_tile(A + (size_t)row0 * D, D, W + (size_t)col0 * D, D, D, sA, sB, tid, acc);
#pragma unroll
        for (int i = 0; i < 4; ++i)
#pragma unroll
            for (int j = 0; j < 4; ++j) {
                const int r = row0 + 4 * ty + i, c = col0 + 4 * tx + j;
                if (c >= NPROJ) continue;
                const float v = acc[i][j] + bias[c];
                if (c < 512) { if (r < ML) Q[(size_t)r * 512 + c] = (bf16)f2bf(v); }
                else if (c < 1024) Kb[(size_t)r * 512 + (c - 512)] = (bf16)f2bf(v * 0.08838834764831845f);
                else if (c < 2048) V[(size_t)r * D + (c - 1024)] = (bf16)f2bf(v);
                else if (c < 3072) { if (r < ML) O[(size_t)r * D + (c - 2048)] = (bf16)f2bf(v); }
                else Gt[(size_t)r * 16 + (c - 3072)] = v;
            }
    }
}

__device__ __forceinline__ void gemm_simple_f32(const bf16* A, int lda, const bf16* Bt, int ldb, int M, int N, int K, float* C, int ldc, const float* bias, LAS unsigned char* lds, int tid, int G) {
    LAS float* sA = (LAS float*)lds; LAS float* sB = sA + 128 * 33;
    const int ty = tid >> 4, tx = tid & 15, ncb = N / 64;
    for (int it = blockIdx.x; it < (M / 128) * ncb; it += G) {
        const int rt = it / ncb, cb = it % ncb, row0 = rt * 128, col0 = cb * 64;
        float acc[4][4];
        ngemm_tile(A + (size_t)row0 * lda, lda, Bt + (size_t)col0 * ldb, ldb, K, sA, sB, tid, acc);
#pragma unroll
        for (int i = 0; i < 4; ++i) { f32x4 o = {acc[i][0], acc[i][1], acc[i][2], acc[i][3]};
            if (bias) o = o + *(const f32x4*)(bias + col0 + 4 * tx);
            *(f32x4*)(C + (size_t)(row0 + 4 * ty + i) * ldc + col0 + 4 * tx) = o; }
    }
}

__device__ __forceinline__ void p7_up_simple(const bf16* A, const bf16* W  , const float* cw  , const float* cb, bf16* ACT, LAS unsigned char* lds, int tid, int G) {
    LAS float* sA = (LAS float*)lds; LAS float* sB = sA + 128 * 33; LAS float* gs = sB + 64 * 33;
    const int ty = tid >> 4, tx = tid & 15;
    constexpr int NCB = FF / 64;
    for (int it = blockIdx.x; it < (ML / 128) * NCB; it += G) {
        const int rt = it / NCB, jb = it % NCB, row0 = rt * 128, j0 = jb * 64;
        const int wrow = (jb >> 1) * 256 + (jb & 1) * 64;
        float u[4][4], g[4][4];
        ngemm_tile(A + (size_t)row0 * D, D, W + (size_t)wrow * D, D, D, sA, sB, tid, u);
        ngemm_tile(A + (size_t)row0 * D, D, W + (size_t)(wrow + 128) * D, D, D, sA, sB, tid, g);
#pragma unroll
        for (int i = 0; i < 4; ++i)
#pragma unroll
            for (int j = 0; j < 4; ++j) gs[(4 * ty + i) * 65 + 4 * tx + j] = g[i][j];
        __syncthreads();
#pragma unroll
        for (int i = 0; i < 4; ++i)
#pragma unroll
            for (int j = 0; j < 4; ++j) {
                const int rl = 4 * ty + i, cl = 4 * tx + j, f = j0 + cl;
                const float gm = (rl & 63) ? gs[(rl - 1) * 65 + cl] : 0.f, gp = ((rl & 63) != 63) ? gs[(rl + 1) * 65 + cl] : 0.f;
                const float gc = gm * cw[f] + g[i][j] * cw[FF + f] + gp * cw[2 * FF + f] + cb[f];
                ACT[(size_t)(row0 + rl) * FF + f] = (bf16)f2bf(silu_f(gc) * u[i][j]);
            }
        __syncthreads();
    }
}

__device__ __forceinline__ void p10_seqmix_simple(const Args& a, LAS unsigned char* lds, int tid, int G) {
    LAS float* sA = (LAS float*)lds; LAS float* sB = sA + 128 * 33;
    const bf16* DF = (const bf16*)(a.ws + WS_DFT); const bf16* HT = (const bf16*)(a.ws + WS_HT); bf16* PQ = (bf16*)(a.ws + WS_PQ);
    const int ty = tid >> 4, tx = tid & 15;
    for (int it = blockIdx.x; it < 8 * 32 * 16; it += G) {
        const int b = it >> 9, rt = (it >> 4) & 31, cbk = it & 15, r0 = rt * 128, c0 = cbk * 64;
        float acc[4][4];
        ngemm_tile(DF + (size_t)r0 * 2048, 2048, HT + ((size_t)b * D + c0) * T, T, 2048, sA, sB, tid, acc);
        const int kind = r0 >> 11, tp0 = r0 & 2047;
#pragma unroll
        for (int i = 0; i < 4; ++i) { u32x2 o; o.x = pk2(acc[i][0], acc[i][1]); o.y = pk2(acc[i][2], acc[i][3]);
            *(u32x2*)(PQ + (size_t)(b * 2048 + tp0 + 4 * ty + i) * 2048 + kind * 1024 + c0 + 4 * tx) = o; }
    }
}

__device__ __forceinline__ void p3_mlstm_simple(const Args& a, LAS unsigned char* lds, int tid, int G) {
    const bf16* Q = (const bf16*)(a.ws + WS_Q); const bf16* Kb = (const bf16*)(a.ws + WS_K); const bf16* V = (const bf16*)(a.ws + WS_V); const float* Gt = (const float*)(a.ws + WS_G);
    LAS float* sq = (LAS float*)lds;
    LAS float* sk = sq + 64 * 128;
    LAS float* sv = sk + 64 * 128;
    LAS float* sg = sv + 64 * 32;
    const int j = tid >> 4, g = tid & 15;
    for (int it = blockIdx.x; it < 64 * 8; it += G) {
        const int bh = it >> 4, dir = (it >> 3) & 1, dvb = it & 7, b = bh >> 2, h = bh & 3;
        bf16* Hout = (bf16*)(a.ws + (dir ? WS_HB : WS_HF));
        float Cst[8], nst[8];
#pragma unroll
        for (int d = 0; d < 8; ++d) { Cst[d] = 0.f; nst[d] = 0.f; }
        for (int sb = 0; sb < 36; ++sb) {
            const bool isctx = sb < 4;
            const int nblk = isctx ? 4 : 32, bi = isctx ? sb : sb - 4;
            const int blk = dir ? (nblk - 1 - bi) : bi;
            const int rowbase = isctx ? (ML + b * TC + blk * 64) : (b * T + blk * 64);
            __syncthreads();
            for (int i = tid; i < 64 * 128; i += NTHR) { const int p = i >> 7, c = i & 127; const int tok = rowbase + (dir ? 63 - p : p);
                sk[i] = bf2f(Kb[(size_t)tok * 512 + h * 128 + c]);
                sq[i] = isctx ? 0.f : bf2f(Q[(size_t)tok * 512 + h * 128 + c]); }
            for (int i = tid; i < 64 * 32; i += NTHR) { const int p = i >> 5, c = i & 31; const int tok = rowbase + (dir ? 63 - p : p);
                sv[i] = bf2f(V[(size_t)tok * D + h * 256 + dvb * 32 + c]); }
            if (tid < 64) { const int tok = rowbase + (dir ? 63 - tid : tid);
                sg[2 * tid] = __expf(Gt[(size_t)tok * 16 + dir * 8 + h]); sg[2 * tid + 1] = __expf(logsigmoid_f(Gt[(size_t)tok * 16 + dir * 8 + 4 + h])); }
            __syncthreads();
            for (int p = 0; p < 64; ++p) {
                const float iv = sg[2 * p], fv = sg[2 * p + 1], vv = sv[p * 32 + j];
                float pn = 0.f, pd = 0.f;
#pragma unroll
                for (int d = 0; d < 8; ++d) { const float kk = sk[p * 128 + 8 * g + d], qq = sq[p * 128 + 8 * g + d];
                    Cst[d] = fv * Cst[d] + iv * kk * vv; nst[d] = fv * nst[d] + iv * kk;
                    pn += qq * Cst[d]; pd += qq * nst[d]; }
                if (!isctx) {
                    pn += __shfl_xor(pn, 1); pn += __shfl_xor(pn, 2); pn += __shfl_xor(pn, 4); pn += __shfl_xor(pn, 8);
                    pd += __shfl_xor(pd, 1); pd += __shfl_xor(pd, 2); pd += __shfl_xor(pd, 4); pd += __shfl_xor(pd, 8);
                    if (g == 0) { const int tok = rowbase + (dir ? 63 - p : p);
                        Hout[(size_t)tok * D + h * 256 + dvb * 32 + j] = (bf16)f2bf(pn / fmaxf(fabsf(pd), 1.0f)); }
                }
            }
        }
    }
}

__global__ void __launch_bounds__(NTHR, 2) mk_fwd(Args a) {
    extern __shared__ __attribute__((aligned(16))) unsigned char lds_raw[];
    LAS unsigned char* lds = (LAS unsigned char*)lds_raw;
    const int tid = threadIdx.x, lane = tid & 63, wave = __builtin_amdgcn_readfirstlane(tid >> 6), G = gridDim.x;
    const int lo = a.ph_lo, hi = a.ph_hi;
    unsigned char* ws = a.ws;
    const float* MOD0 = (const float*)(ws + WS_MOD); const float* MOD1 = MOD0 + 9 * 6144;
#define IN(k) (lo <= (k) && (k) < hi)
#define SEAM(k) do { if (IN(k) && IN((k) + 1)) { __threadfence(); cg::this_grid().sync(); } } while (0)

    if (IN(0)) { p0_prep(a, lds, tid, lane, wave, G); } SEAM(0);
    if (IN(1)) { p1_norm_mod(a, lane, wave, G); } SEAM(1);
    if (IN(2)) { p2_inproj_simple(a, lds, tid, G); } SEAM(2);
    if (IN(3)) { p3_mlstm_simple(a, lds, tid, G); } SEAM(3);
    if (IN(4)) { p4_readout(a, lane, wave, G); } SEAM(4);
    if (IN(5)) { gemm_simple_f32((const bf16*)(ws + WS_Y), D, (const bf16*)(ws + WS_WOUT), D, ML, D, D, (float*)(ws + WS_Y1), D, nullptr, lds, tid, G); } SEAM(5);
    if (IN(6)) { rowpass<1>((const float*)(ws + WS_Y1), a.in[0], a.out, MOD0 + 2 * D, a.in[7], a.in[8], MOD0 + 3 * D, MOD0 + 4 * D, (bf16*)(ws + WS_H2), lane, wave, G); } SEAM(6);
    if (IN(7)) { p7_up_simple((const bf16*)(ws + WS_H2), (const bf16*)(ws + WS_WUP), a.in[11], a.in[12], (bf16*)(ws + WS_ACT), lds, tid, G); } SEAM(7);
    if (IN(8)) { gemm_simple_f32((const bf16*)(ws + WS_ACT), FF, (const bf16*)(ws + WS_WDN), FF, ML, D, FF, (float*)(ws + WS_Y2), D, nullptr, lds, tid, G); } SEAM(8);
    if (IN(9)) { rowpass_t((const float*)(ws + WS_Y2), a.out, a.out, MOD0 + 5 * D, a.in[9], a.in[6] + D, MOD1, MOD1 + D, (bf16*)(ws + WS_HT), lds, tid, lane, wave, G); } SEAM(9);
    if (IN(10)) { p10_seqmix_simple(a, lds, tid, G); } SEAM(10);
    if (IN(11)) { gemm_simple_f32((const bf16*)(ws + WS_PQ), 2048, (const bf16*)(ws + WS_WCS), 2048, ML, D, 2048, (float*)(ws + WS_Y3), D, a.in[19], lds, tid, G); } SEAM(11);
    if (IN(12)) { rowpass<1>((const float*)(ws + WS_Y3), a.out, a.out, MOD1 + 2 * D, a.in[7] + D, a.in[8] + D, MOD1 + 3 * D, MOD1 + 4 * D, (bf16*)(ws + WS_H2B), lane, wave, G); } SEAM(12);
    if (IN(13)) { p7_up_simple((const bf16*)(ws + WS_H2B), (const bf16*)(ws + WS_WUP) + (size_t)NUP * D, a.in[11] + 3 * FF, a.in[12] + FF, (bf16*)(ws + WS_ACT1), lds, tid, G); } SEAM(13);
    if (IN(14)) { gemm_simple_f32((const bf16*)(ws + WS_ACT1), FF, (const bf16*)(ws + WS_WDN) + (size_t)D * FF, FF, ML, D, FF, (float*)(ws + WS_Y2B), D, nullptr, lds, tid, G); } SEAM(14);
    if (IN(15)) { rowpass<0>((const float*)(ws + WS_Y2B), a.out, a.out, MOD1 + 5 * D, a.in[9] + D, nullptr, nullptr, nullptr, nullptr, lane, wave, G); }
#undef IN
#undef SEAM
}

extern "C" void kernel_launch(void* const* d_in, const int* in_sizes, int n_in, void* d_out, int out_size, void* d_ws, size_t ws_size, hipStream_t stream) {
    static int grid = 0;
    if (grid == 0) {
        if (n_in != 20 || out_size != ML * D || ws_size < WS_END) { fprintf(stderr, "kernel_launch: unexpected shapes (n_in %d out %d ws %zu)\n", n_in, out_size, ws_size); grid = -1; return; }
        int dev = 0, cus = 0, per_cu = 0;
        (void)hipGetDevice(&dev); (void)hipDeviceGetAttribute(&cus, hipDeviceAttributeMultiprocessorCount, dev);
        (void)hipFuncSetAttribute((const void*)mk_fwd, hipFuncAttributeMaxDynamicSharedMemorySize, LDS_BYTES);
        (void)hipOccupancyMaxActiveBlocksPerMultiprocessor(&per_cu, (const void*)mk_fwd, NTHR, LDS_BYTES);
        if (per_cu < 1) { fprintf(stderr, "kernel_launch: occupancy query says %d blocks/CU\n", per_cu); per_cu = 1; }
        grid = cus * 1;
        (void)hipGetLastError();
    }
    if (grid < 0) return;
    (void)hipMemsetAsync((char*)d_ws + WS_CTL, 0, 1 * MiB, stream);
    Args a{};
    for (int i = 0; i < 20; ++i) a.in[i] = (const float*)d_in[i];
    a.out = (float*)d_out; a.ws = (unsigned char*)d_ws;
    if (MK_N_LAUNCHES == 1) {
        a.ph_lo = 0; a.ph_hi = NPH;
        void* args[] = {&a};
        hipError_t e = hipLaunchCooperativeKernel((const void*)mk_fwd, dim3(grid), dim3(NTHR), args, LDS_BYTES, stream);
        if (e != hipSuccess) fprintf(stderr, "cooperative launch failed: %s (grid %d)\n", hipGetErrorString(e), grid);
    } else {
        for (int p = 0; p < NPH; ++p) { a.ph_lo = p; a.ph_hi = p + 1;
            hipLaunchKernelGGL(mk_fwd, dim3(grid), dim3(NTHR), LDS_BYTES, stream, a); }
    }
}
```

```cpp
#include <hip/hip_runtime.h>
#include <hip/hip_cooperative_groups.h>
#include <cstdio>
#include <cstdint>
namespace cg = cooperative_groups;

#ifndef MK_N_LAUNCHES
#define MK_N_LAUNCHES 1
#endif

#define GAS __attribute__((address_space(1)))
#define LAS __attribute__((address_space(3)))
typedef unsigned short bf16;
typedef float f32x4 __attribute__((ext_vector_type(4)));
typedef unsigned u32x4 __attribute__((ext_vector_type(4)));
typedef unsigned u32x2 __attribute__((ext_vector_type(2)));

constexpr int D = 1024, NB = 8, T = 2048, TC = 256;
constexpr int ML = NB * T;
constexpr int MC = NB * TC;
constexpr int MALL = ML + MC;
constexpr int NH = 4, DK = 128, DV = 256;
constexpr int NPROJ = 3088, NPROJ_PAD = 3328;
constexpr int FF = 2816, NUP = 2 * FF;
constexpr float EPS = 1e-6f;
constexpr int NPH = 16;
constexpr int NWAVES = 8, NTHR = 512;

constexpr size_t MiB = 1u << 20;
constexpr size_t WS_CTL = 0;
constexpr size_t WS_MOD = 1 * MiB;
constexpr size_t WS_WIN = 2 * MiB;
constexpr size_t WS_WOUT = WS_WIN + (size_t)NPROJ_PAD * D * 2;
constexpr size_t WS_WUP = WS_WOUT + (size_t)D * D * 2;
constexpr size_t WS_WDN = WS_WUP + (size_t)2 * NUP * D * 2;
constexpr size_t WS_WCS = WS_WDN + (size_t)2 * D * FF * 2;
constexpr size_t WS_DFT = WS_WCS + (size_t)D * 2048 * 2;
constexpr size_t WS_A = WS_DFT + (size_t)4096 * 2048 * 2;
constexpr size_t WS_C = WS_A + (size_t)MALL * D * 2;
constexpr size_t WS_B = WS_C + (size_t)ML * D * 2;
constexpr size_t WS_Q = WS_B;
constexpr size_t WS_K = WS_Q + (size_t)ML * 512 * 2;
constexpr size_t WS_V = WS_K + (size_t)MALL * 512 * 2;
constexpr size_t WS_O = WS_V + (size_t)MALL * D * 2;
constexpr size_t WS_G = WS_O + (size_t)ML * D * 2;
constexpr size_t WS_END = WS_B + 104 * MiB;
static_assert(WS_G + (size_t)MALL * 16 * 4 <= WS_END, "region B");
static_assert(WS_END <= 256 * MiB, "workspace");
constexpr size_t WS_HF = WS_A;
constexpr size_t WS_HB = WS_C;
constexpr size_t WS_Y = WS_Q;
constexpr size_t WS_Y1 = WS_V;
constexpr size_t WS_H2 = WS_A;
constexpr size_t WS_ACT = WS_B;
constexpr size_t WS_Y2 = WS_A;
constexpr size_t WS_HT = WS_B;
constexpr size_t WS_PQ = WS_B + 32 * MiB;
constexpr size_t WS_Y3 = WS_A;
constexpr size_t WS_H2B = WS_B + 72 * MiB;
constexpr size_t WS_ACT1 = WS_A;
constexpr size_t WS_Y2B = WS_B + 24 * MiB;
static_assert(WS_V + (size_t)ML * D * 4 <= WS_G, "y1 overlay");
static_assert(WS_ACT1 + (size_t)ML * FF * 2 <= WS_H2B && WS_ACT1 + (size_t)ML * FF * 2 <= WS_Y2B, "layer-1 overlays");
static_assert(WS_Y2B + (size_t)ML * D * 4 <= WS_END && WS_H2B + (size_t)ML * D * 2 <= WS_END && WS_PQ + (size_t)ML * 2048 * 2 <= WS_END, "layer-1 overlays");

constexpr int LDS_BYTES = 147456;

__device__ __forceinline__ float bf2f(unsigned v) { return __uint_as_float(v << 16); }
__device__ __forceinline__ unsigned f2bf(float f) { unsigned u = __float_as_uint(f); return (u + 0x7fffu + ((u >> 16) & 1u)) >> 16; }
__device__ __forceinline__ unsigned pk2(float lo, float hi) { return f2bf(lo) | (f2bf(hi) << 16); }
__device__ __forceinline__ float silu_f(float v) { return v / (1.f + __expf(-v)); }
__device__ __forceinline__ float sigmoid_f(float v) { return 1.f / (1.f + __expf(-v)); }
__device__ __forceinline__ float logsigmoid_f(float v) { return fminf(v, 0.f) - log1pf(__expf(-fabsf(v))); }
__device__ __forceinline__ float wave_sum(float v) {
#pragma unroll
    for (int o = 1; o < 64; o <<= 1) v += __shfl_xor(v, o);
    return v;
}

struct Args { const float* in[20]; float* out; unsigned char* ws; int ph_lo, ph_hi; };

template <int MODE>
__device__ __forceinline__ void p0_transpose_item(const float* W, int K, int N, bf16* WT, LAS float* scr, int item, int nblk, int lane) {
    const int kb = item / nblk, nb = item % nblk, k0 = 64 * kb, n0 = 32 * nb;
#pragma unroll 8
    for (int i = 0; i < 32; ++i) { const int kk = 2 * i + (lane >> 5); const int n = n0 + (lane & 31);
        scr[kk * 33 + (lane & 31)] = (n < N) ? W[(size_t)(k0 + kk) * N + n] : 0.f; }
    asm volatile("s_waitcnt lgkmcnt(0)" ::: "memory");
    const int c = lane & 7;
#pragma unroll
    for (int j = 0; j < 4; ++j) { const int nl = (lane >> 3) + 8 * j; const LAS float* s = scr + (8 * c) * 33 + nl;
        u32x4 o; o.x = pk2(s[0 * 33], s[1 * 33]); o.y = pk2(s[2 * 33], s[3 * 33]); o.z = pk2(s[4 * 33], s[5 * 33]); o.w = pk2(s[6 * 33], s[7 * 33]);
        int n = n0 + nl, dr = n;
        if (MODE == 1) { const int isg = n >= FF ? 1 : 0; const int jj = n - isg * FF; dr = (jj >> 7) * 256 + isg * 128 + (jj & 127); }
        *(u32x4*)(WT + (size_t)dr * K + k0 + 8 * c) = o; }
    asm volatile("s_waitcnt lgkmcnt(0)" ::: "memory");
}

__device__ __forceinline__ void p0_prep(const Args& a, LAS unsigned char* lds, int tid, int lane, int wave, int G) {
    unsigned char* ws = a.ws;
    {
        LAS float* scr = (LAS float*)(lds + wave * 16384);
        const int gw = blockIdx.x * NWAVES + wave, NGW = G * NWAVES;
        constexpr int I_IN = 16 * (NPROJ_PAD / 32), I_OUT = 16 * 32, I_UP = 16 * (NUP / 32), I_DN = (FF / 64) * 32;
        constexpr int NIT = I_IN + I_OUT + 2 * I_UP + 2 * I_DN;
        for (int it = gw; it < NIT; it += NGW) {
            int r = it;
            if (r < I_IN) { p0_transpose_item<0>(a.in[14], D, NPROJ, (bf16*)(ws + WS_WIN), scr, r, NPROJ_PAD / 32, lane); continue; } r -= I_IN;
            if (r < I_OUT) { p0_transpose_item<0>(a.in[17], D, D, (bf16*)(ws + WS_WOUT), scr, r, 32, lane); continue; } r -= I_OUT;
            if (r < I_UP) { p0_transpose_item<1>(a.in[10], D, NUP, (bf16*)(ws + WS_WUP), scr, r, NUP / 32, lane); continue; } r -= I_UP;
            if (r < I_UP) { p0_transpose_item<1>(a.in[10] + (size_t)D * NUP, D, NUP, (bf16*)(ws + WS_WUP) + (size_t)NUP * D, scr, r, NUP / 32, lane); continue; } r -= I_UP;
            if (r < I_DN) { p0_transpose_item<0>(a.in[13], FF, D, (bf16*)(ws + WS_WDN), scr, r, 32, lane); continue; } r -= I_DN;
            p0_transpose_item<0>(a.in[13] + (size_t)FF * D, FF, D, (bf16*)(ws + WS_WDN) + (size_t)D * FF, scr, r, 32, lane);
        }
    }
    __syncthreads();
    LAS float* tab = (LAS float*)(lds + 131072);
    for (int i = tid; i < 2048; i += NTHR) tab[i] = cospif((float)i * (1.0f / 1024.0f));
    __syncthreads();
    {
        bf16* DF = (bf16*)(ws + WS_DFT);
        const int total = 4096 * 256;
        for (int idx = blockIdx.x * NTHR + tid; idx < total; idx += G * NTHR) {
            const int r = idx >> 8, t0 = (idx & 255) * 8, tp = r & 2047, sh = (r >> 11) ? 512 : 0;
            float v[8];
#pragma unroll
            for (int j = 0; j < 8; ++j) v[j] = tab[(tp * (t0 + j) + sh) & 2047] * (1.0f / 512.0f);
            u32x4 o; o.x = pk2(v[0], v[1]); o.y = pk2(v[2], v[3]); o.z = pk2(v[4], v[5]); o.w = pk2(v[6], v[7]);
            *(u32x4*)(DF + (size_t)r * 2048 + t0) = o;
        }
    }
    {
        const float* W = a.in[18]; bf16* WCS = (bf16*)(ws + WS_WCS);
        LAS float* wt = (LAS float*)lds;
        for (int it = blockIdx.x; it < 8 * 16; it += G) {
            const int g = it >> 4, n0 = (it & 15) * 64;
            __syncthreads();
            for (int i = tid; i < 128 * 64; i += NTHR) wt[i] = W[(size_t)(g * 128 + (i >> 6)) * D + n0 + (i & 63)];
            __syncthreads();
            const int nl = tid >> 3, cgp = tid & 7;
            float ac[16], as[16];
#pragma unroll
            for (int j = 0; j < 16; ++j) { ac[j] = 0.f; as[j] = 0.f; }
            for (int cp = 0; cp < 128; ++cp) {
                const float w = wt[cp * 64 + nl];
#pragma unroll
                for (int j = 0; j < 16; ++j) { const int c = 16 * cgp + j; const int ph = (c * cp) & 127;
                    ac[j] += tab[ph * 16] * w; as[j] += tab[((ph * 16) + 1536) & 2047] * w; }
            }
            bf16* dst = WCS + (size_t)(n0 + nl) * 2048 + g * 128 + 16 * cgp;
            u32x4 o0, o1;
            o0.x = pk2(ac[0], ac[1]); o0.y = pk2(ac[2], ac[3]); o0.z = pk2(ac[4], ac[5]); o0.w = pk2(ac[6], ac[7]);
            o1.x = pk2(ac[8], ac[9]); o1.y = pk2(ac[10], ac[11]); o1.z = pk2(ac[12], ac[13]); o1.w = pk2(ac[14], ac[15]);
            *(u32x4*)dst = o0; *(u32x4*)(dst + 8) = o1;
            o0.x = pk2(as[0], as[1]); o0.y = pk2(as[2], as[3]); o0.z = pk2(as[4], as[5]); o0.w = pk2(as[6], as[7]);
            o1.x = pk2(as[8], as[9]); o1.y = pk2(as[10], as[11]); o1.z = pk2(as[12], as[13]); o1.w = pk2(as[14], as[15]);
            *(u32x4*)(dst + 1024) = o0; *(u32x4*)(dst + 1024 + 8) = o1;
        }
    }
    __syncthreads();
    {
        LAS float* sc = (LAS float*)lds;
        LAS float* red = (LAS float*)(lds + 40960);
        for (int i = tid; i < 9 * 1024; i += NTHR) { const float v = (i < 8 * 1024) ? a.in[1][i] : a.in[3][i - 8 * 1024]; sc[i] = silu_f(v); }
        __syncthreads();
        float* MOD = (float*)(ws + WS_MOD);
        for (int it = blockIdx.x; it < 2 * 96; it += G) {
            const int l = it / 96, c0 = (it % 96) * 64;
            const float* Wl = a.in[4] + (size_t)l * D * 6144 + c0 + lane;
            float acc[9];
#pragma unroll
            for (int r = 0; r < 9; ++r) acc[r] = 0.f;
            const int kb = wave * 128;
#pragma unroll 4
            for (int k = 0; k < 128; ++k) { const float w = Wl[(size_t)(kb + k) * 6144];
#pragma unroll
                for (int r = 0; r < 9; ++r) acc[r] += sc[r * 1024 + kb + k] * w; }
#pragma unroll
            for (int r = 0; r < 9; ++r) red[(wave * 9 + r) * 64 + lane] = acc[r];
            __syncthreads();
            for (int i = tid; i < 9 * 64; i += NTHR) { float s = 0.f;
#pragma unroll
                for (int w = 0; w < 8; ++w) s += red[w * 576 + i];
                const int r = i >> 6, cl = i & 63;
                MOD[((size_t)l * 9 + r) * 6144 + c0 + cl] = s + a.in[5][(size_t)l * 6144 + c0 + cl]; }
            __syncthreads();
        }
    }
}

__device__ __forceinline__ void load_row_f32(const float* p, int lane, f32x4 (&v)[4]) {
#pragma unroll
    for (int j = 0; j < 4; ++j) v[j] = *(const f32x4*)(p + 4 * lane + 256 * j);
}
__device__ __forceinline__ float row_sumsq(const f32x4 (&v)[4]) {
    float s = 0.f;
#pragma unroll
    for (int j = 0; j < 4; ++j) s += (v[j].x * v[j].x + v[j].y * v[j].y) + (v[j].z * v[j].z + v[j].w * v[j].w);
    return wave_sum(s);
}

__device__ __forceinline__ void p1_norm_mod(const Args& a, int lane, int wave, int G) {
    const float* MOD = (const float*)(a.ws + WS_MOD);
    bf16* A = (bf16*)(a.ws + WS_A);
    const float* g = a.in[6];
    const int gw = blockIdx.x * NWAVES + wave, NGW = G * NWAVES;
    for (int m = gw; m < MALL; m += NGW) {
        const float* xr = (m < ML) ? a.in[0] + (size_t)m * D : a.in[2] + (size_t)(m - ML) * D;
        const int mr = (m < ML) ? (m >> 11) : 8;
        const float* sh = MOD + (size_t)mr * 6144, * sc = sh + D;
        f32x4 v[4]; load_row_f32(xr, lane, v);
        const float rs = rsqrtf(row_sumsq(v) * (1.f / D) + EPS);
#pragma unroll
        for (int j = 0; j < 4; ++j) { const int c = 4 * lane + 256 * j;
            const f32x4 gg = *(const f32x4*)(g + c), s1 = *(const f32x4*)(sc + c), s0 = *(const f32x4*)(sh + c);
            const f32x4 h = v[j] * rs * gg * (1.f + s1) + s0;
            u32x2 o; o.x = pk2(h.x, h.y); o.y = pk2(h.z, h.w);
            *(u32x2*)(A + (size_t)m * D + c) = o; }
    }
}

__device__ __forceinline__ void p4_readout(const Args& a, int lane, int wave, int G) {
    const bf16* HF = (const bf16*)(a.ws + WS_HF); const bf16* HB = (const bf16*)(a.ws + WS_HB); const bf16* O = (const bf16*)(a.ws + WS_O);
    bf16* Y = (bf16*)(a.ws + WS_Y); const float* ng = a.in[16];
    const int gw = blockIdx.x * NWAVES + wave, NGW = G * NWAVES;
    for (int m = gw; m < ML; m += NGW) {
        const size_t off = (size_t)m * D + 16 * lane;
        const u32x4 f0 = *(const u32x4*)(HF + off), f1 = *(const u32x4*)(HF + off + 8);
        const u32x4 b0 = *(const u32x4*)(HB + off), b1 = *(const u32x4*)(HB + off + 8);
        const u32x4 o0 = *(const u32x4*)(O + off), o1 = *(const u32x4*)(O + off + 8);
        float h[16], og[16];
        const unsigned fw[8] = {f0.x, f0.y, f0.z, f0.w, f1.x, f1.y, f1.z, f1.w};
        const unsigned bw[8] = {b0.x, b0.y, b0.z, b0.w, b1.x, b1.y, b1.z, b1.w};
        const unsigned ow[8] = {o0.x, o0.y, o0.z, o0.w, o1.x, o1.y, o1.z, o1.w};
        float ss = 0.f;
#pragma unroll
        for (int j = 0; j < 8; ++j) {
            h[2 * j] = bf2f(fw[j] & 0xffffu) + bf2f(bw[j] & 0xffffu); h[2 * j + 1] = bf2f(fw[j] >> 16) + bf2f(bw[j] >> 16);
            og[2 * j] = bf2f(ow[j] & 0xffffu); og[2 * j + 1] = bf2f(ow[j] >> 16);
            ss += h[2 * j] * h[2 * j] + h[2 * j + 1] * h[2 * j + 1]; }
        ss += __shfl_xor(ss, 1); ss += __shfl_xor(ss, 2); ss += __shfl_xor(ss, 4); ss += __shfl_xor(ss, 8);
        const float rs = rsqrtf(ss * (1.f / DV) + EPS);
        unsigned w[8];
#pragma unroll
        for (int j = 0; j < 8; ++j) {
            const float y0 = h[2 * j] * rs * ng[16 * lane + 2 * j] * sigmoid_f(og[2 * j]);
            const float y1 = h[2 * j + 1] * rs * ng[16 * lane + 2 * j + 1] * sigmoid_f(og[2 * j + 1]);
            w[j] = pk2(y0, y1); }
        *(u32x4*)(Y + off) = (u32x4){w[0], w[1], w[2], w[3]}; *(u32x4*)(Y + off + 8) = (u32x4){w[4], w[5], w[6], w[7]};
    }
}

template <int NEXT>
__device__ __forceinline__ void rowpass(const float* Y, const float* xin, float* xout, const float* gate  , const float* post_g,
                                        const float* ng, const float* shp, const float* scp, bf16* Hout, int lane, int wave, int G) {
    const int gw = blockIdx.x * NWAVES + wave, NGW = G * NWAVES;
    for (int m = gw; m < ML; m += NGW) {
        const int b = m >> 11;
        f32x4 y[4], x[4]; load_row_f32(Y + (size_t)m * D, lane, y); load_row_f32(xin + (size_t)m * D, lane, x);
        const float rs = rsqrtf(row_sumsq(y) * (1.f / D) + EPS);
#pragma unroll
        for (int j = 0; j < 4; ++j) { const int c = 4 * lane + 256 * j;
            const f32x4 gt = *(const f32x4*)(gate + (size_t)b * 6144 + c), pg = *(const f32x4*)(post_g + c);
            x[j] = x[j] + gt * (y[j] * rs * pg);
            *(f32x4*)(xout + (size_t)m * D + c) = x[j]; }
        if (NEXT == 1) {
            const float rs2 = rsqrtf(row_sumsq(x) * (1.f / D) + EPS);
#pragma unroll
            for (int j = 0; j < 4; ++j) { const int c = 4 * lane + 256 * j;
                const f32x4 gg = *(const f32x4*)(ng + c), s1 = *(const f32x4*)(scp + (size_t)b * 6144 + c), s0 = *(const f32x4*)(shp + (size_t)b * 6144 + c);
                const f32x4 h = x[j] * rs2 * gg * (1.f + s1) + s0;
                u32x2 o; o.x = pk2(h.x, h.y); o.y = pk2(h.z, h.w);
                *(u32x2*)(Hout + (size_t)m * D + c) = o; }
        }
    }
}
__device__ __forceinline__ void rowpass_t(const float* Y, const float* xin, float* xout, const float* gate, const float* post_g,
                                          const float* ng, const float* shp, const float* scp, bf16* HT, LAS unsigned char* lds, int tid, int lane, int wave, int G) {
    constexpr int PITCH = 1024 + 8;
    LAS bf16* tile = (LAS bf16*)lds;
    for (int it = blockIdx.x; it < ML / 64; it += G) {
        const int m0 = it * 64, b = m0 >> 11, t0 = m0 & 2047;
        __syncthreads();
        for (int rr = 0; rr < 8; ++rr) {
            const int r = wave * 8 + rr, m = m0 + r;
            f32x4 y[4], x[4]; load_row_f32(Y + (size_t)m * D, lane, y); load_row_f32(xin + (size_t)m * D, lane, x);
            const float rs = rsqrtf(row_sumsq(y) * (1.f / D) + EPS);
#pragma unroll
            for (int j = 0; j < 4; ++j) { const int c = 4 * lane + 256 * j;
                const f32x4 gt = *(const f32x4*)(gate + (size_t)b * 6144 + c), pg = *(const f32x4*)(post_g + c);
                x[j] = x[j] + gt * (y[j] * rs * pg);
                *(f32x4*)(xout + (size_t)m * D + c) = x[j]; }
            const float rs2 = rsqrtf(row_sumsq(x) * (1.f / D) + EPS);
#pragma unroll
            for (int j = 0; j < 4; ++j) { const int c = 4 * lane + 256 * j;
                const f32x4 gg = *(const f32x4*)(ng + c), s1 = *(const f32x4*)(scp + (size_t)b * 6144 + c), s0 = *(const f32x4*)(shp + (size_t)b * 6144 + c);
                const f32x4 h = x[j] * rs2 * gg * (1.f + s1) + s0;
                u32x2 o; o.x = pk2(h.x, h.y); o.y = pk2(h.z, h.w);
                *(LAS u32x2*)(tile + r * PITCH + c) = o; }
        }
        __syncthreads();
        unsigned lo[32], hi[32];
#pragma unroll
        for (int t = 0; t < 64; t += 2) {
            const unsigned w0 = *(const LAS unsigned*)(tile + t * PITCH + 2 * tid), w1 = *(const LAS unsigned*)(tile + (t + 1) * PITCH + 2 * tid);
            lo[t >> 1] = (w0 & 0xffffu) | (w1 << 16); hi[t >> 1] = (w0 >> 16) | (w1 & 0xffff0000u); }
        bf16* d0 = HT + ((size_t)b * D + 2 * tid) * T + t0; bf16* d1 = d0 + T;
#pragma unroll
        for (int q = 0; q < 8; ++q) { *(u32x4*)(d0 + 8 * q) = (u32x4){lo[4 * q], lo[4 * q + 1], lo[4 * q + 2], lo[4 * q + 3]};
                                      *(u32x4*)(d1 + 8 * q) = (u32x4){hi[4 * q], hi[4 * q + 1], hi[4 * q + 2], hi[4 * q + 3]}; }
    }
}

__device__ __forceinline__ void ngemm_tile(const bf16* A, int lda, const bf16* Bt, int ldb, int K, LAS float* sA, LAS float* sB, int tid, float (&acc)[4][4]) {
#pragma unroll
    for (int i = 0; i < 4; ++i)
#pragma unroll
        for (int j = 0; j < 4; ++j) acc[i][j] = 0.f;
    const int ty = tid >> 4, tx = tid & 15;
    for (int k0 = 0; k0 < K; k0 += 32) {
        { const u32x4 v = *(const u32x4*)(A + (size_t)(tid >> 2) * lda + k0 + (tid & 3) * 8);
          LAS float* d = sA + (tid >> 2) * 33 + (tid & 3) * 8;
          d[0] = bf2f(v.x & 0xffffu); d[1] = bf2f(v.x >> 16); d[2] = bf2f(v.y & 0xffffu); d[3] = bf2f(v.y >> 16);
          d[4] = bf2f(v.z & 0xffffu); d[5] = bf2f(v.z >> 16); d[6] = bf2f(v.w & 0xffffu); d[7] = bf2f(v.w >> 16); }
        { const u32x2 v = *(const u32x2*)(Bt + (size_t)(tid >> 3) * ldb + k0 + (tid & 7) * 4);
          LAS float* d = sB + (tid >> 3) * 33 + (tid & 7) * 4;
          d[0] = bf2f(v.x & 0xffffu); d[1] = bf2f(v.x >> 16); d[2] = bf2f(v.y & 0xffffu); d[3] = bf2f(v.y >> 16); }
        __syncthreads();
#pragma unroll 8
        for (int k = 0; k < 32; ++k) {
            float av[4], bv[4];
#pragma unroll
            for (int i = 0; i < 4; ++i) { av[i] = sA[(4 * ty + i) * 33 + k]; bv[i] = sB[(4 * tx + i) * 33 + k]; }
#pragma unroll
            for (int i = 0; i < 4; ++i)
#pragma unroll
                for (int j = 0; j < 4; ++j) acc[i][j] += av[i] * bv[j];
        }
        __syncthreads();
    }
}

__device__ __forceinline__ void p2_inproj_simple(const Args& a, LAS unsigned char* lds, int tid, int G) {
    LAS float* sA = (LAS float*)lds; LAS float* sB = sA + 128 * 33;
    const bf16* A = (const bf16*)(a.ws + WS_A); const bf16* W = (const bf16*)(a.ws + WS_WIN);
    bf16* Q = (bf16*)(a.ws + WS_Q); bf16* Kb = (bf16*)(a.ws + WS_K); bf16* V = (bf16*)(a.ws + WS_V); bf16* O = (bf16*)(a.ws + WS_O); float* Gt = (float*)(a.ws + WS_G);
    const float* bias = a.in[15];
    constexpr int NCB = 49;
    const int ty = tid >> 4, tx = tid & 15;
    for (int it = blockIdx.x; it < (MALL / 128) * NCB; it += G) {
        const int rt = it / NCB, cb = it % NCB, row0 = rt * 128, col0 = cb * 64;
        float acc[4][4];
        ngemm_tile(A + (size_t)row0 * D, D, W + (size_t)col0 * D, D, D, sA, sB, tid, acc);
#pragma unroll
        for (int i = 0; i < 4; ++i)
#pragma unroll
            for (int j = 0; j < 4; ++j) {
                const int r = row0 + 4 * ty + i, c = col0 + 4 * tx + j;
                if (c >= NPROJ) continue;
                const float v = acc[i][j] + bias[c];
                if (c < 512) { if (r < ML) Q[(size_t)r * 512 + c] = (bf16)f2bf(v); }
                else if (c < 1024) Kb[(size_t)r * 512 + (c - 512)] = (bf16)f2bf(v * 0.08838834764831845f);
                else if (c < 2048) V[(size_t)r * D + (c - 1024)] = (bf16)f2bf(v);
                else if (c < 3072) { if (r < ML) O[(size_t)r * D + (c - 2048)] = (bf16)f2bf(v); }
                else Gt[(size_t)r * 16 + (c - 3072)] = v;
            }
    }
}

__device__ __forceinline__ void gemm_simple_f32(const bf16* A, int lda, const bf16* Bt, int ldb, int M, int N, int K, float* C, int ldc, const float* bias, LAS unsigned char* lds, int tid, int G) {
    LAS float* sA = (LAS float*)lds; LAS float* sB = sA + 128 * 33;
    const int ty = tid >> 4, tx = tid & 15, ncb = N / 64;
    for (int it = blockIdx.x; it < (M / 128) * ncb; it += G) {
        const int rt = it / ncb, cb = it % ncb, row0 = rt * 128, col0 = cb * 64;
        float acc[4][4];
        ngemm_tile(A + (size_t)row0 * lda, lda, Bt + (size_t)col0 * ldb, ldb, K, sA, sB, tid, acc);
#pragma unroll
        for (int i = 0; i < 4; ++i) { f32x4 o = {acc[i][0], acc[i][1], acc[i][2], acc[i][3]};
            if (bias) o = o + *(const f32x4*)(bias + col0 + 4 * tx);
            *(f32x4*)(C + (size_t)(row0 + 4 * ty + i) * ldc + col0 + 4 * tx) = o; }
    }
}

__device__ __forceinline__ void p7_up_simple(const bf16* A, const bf16* W  , const float* cw  , const float* cb, bf16* ACT, LAS unsigned char* lds, int tid, int G) {
    LAS float* sA = (LAS float*)lds; LAS float* sB = sA + 128 * 33; LAS float* gs = sB + 64 * 33;
    const int ty = tid >> 4, tx = tid & 15;
    constexpr int NCB = FF / 64;
    for (int it = blockIdx.x; it < (ML / 128) * NCB; it += G) {
        const int rt = it / NCB, jb = it % NCB, row0 = rt * 128, j0 = jb * 64;
        const int wrow = (jb >> 1) * 256 + (jb & 1) * 64;
        float u[4][4], g[4][4];
        ngemm_tile(A + (size_t)row0 * D, D, W + (size_t)wrow * D, D, D, sA, sB, tid, u);
        ngemm_tile(A + (size_t)row0 * D, D, W + (size_t)(wrow + 128) * D, D, D, sA, sB, tid, g);
#pragma unroll
        for (int i = 0; i < 4; ++i)
#pragma unroll
            for (int j = 0; j < 4; ++j) gs[(4 * ty + i) * 65 + 4 * tx + j] = g[i][j];
        __syncthreads();
#pragma unroll
        for (int i = 0; i < 4; ++i)
#pragma unroll
            for (int j = 0; j < 4; ++j) {
                const int rl = 4 * ty + i, cl = 4 * tx + j, f = j0 + cl;
                const float gm = (rl & 63) ? gs[(rl - 1) * 65 + cl] : 0.f, gp = ((rl & 63) != 63) ? gs[(rl + 1) * 65 + cl] : 0.f;
                const float gc = gm * cw[f] + g[i][j] * cw[FF + f] + gp * cw[2 * FF + f] + cb[f];
                ACT[(size_t)(row0 + rl) * FF + f] = (bf16)f2bf(silu_f(gc) * u[i][j]);
            }
        __syncthreads();
    }
}

__device__ __forceinline__ void p10_seqmix_simple(const Args& a, LAS unsigned char* lds, int tid, int G) {
    LAS float* sA = (LAS float*)lds; LAS float* sB = sA + 128 * 33;
    const bf16* DF = (const bf16*)(a.ws + WS_DFT); const bf16* HT = (const bf16*)(a.ws + WS_HT); bf16* PQ = (bf16*)(a.ws + WS_PQ);
    const int ty = tid >> 4, tx = tid & 15;
    for (int it = blockIdx.x; it < 8 * 32 * 16; it += G) {
        const int b = it >> 9, rt = (it >> 4) & 31, cbk = it & 15, r0 = rt * 128, c0 = cbk * 64;
        float acc[4][4];
        ngemm_tile(DF + (size_t)r0 * 2048, 2048, HT + ((size_t)b * D + c0) * T, T, 2048, sA, sB, tid, acc);
        const int kind = r0 >> 11, tp0 = r0 & 2047;
#pragma unroll
        for (int i = 0; i < 4; ++i) { u32x2 o; o.x = pk2(acc[i][0], acc[i][1]); o.y = pk2(acc[i][2], acc[i][3]);
            *(u32x2*)(PQ + (size_t)(b * 2048 + tp0 + 4 * ty + i) * 2048 + kind * 1024 + c0 + 4 * tx) = o; }
    }
}

__device__ __forceinline__ void p3_mlstm_simple(const Args& a, LAS unsigned char* lds, int tid, int G) {
    const bf16* Q = (const bf16*)(a.ws + WS_Q); const bf16* Kb = (const bf16*)(a.ws + WS_K); const bf16* V = (const bf16*)(a.ws + WS_V); const float* Gt = (const float*)(a.ws + WS_G);
    LAS float* sq = (LAS float*)lds;
    LAS float* sk = sq + 64 * 128;
    LAS float* sv = sk + 64 * 128;
    LAS float* sg = sv + 64 * 32;
    const int j = tid >> 4, g = tid & 15;
    for (int it = blockIdx.x; it < 64 * 8; it += G) {
        const int bh = it >> 4, dir = (it >> 3) & 1, dvb = it & 7, b = bh >> 2, h = bh & 3;
        bf16* Hout = (bf16*)(a.ws + (dir ? WS_HB : WS_HF));
        float Cst[8], nst[8];
#pragma unroll
        for (int d = 0; d < 8; ++d) { Cst[d] = 0.f; nst[d] = 0.f; }
        for (int sb = 0; sb < 36; ++sb) {
            const bool isctx = sb < 4;
            const int nblk = isctx ? 4 : 32, bi = isctx ? sb : sb - 4;
            const int blk = dir ? (nblk - 1 - bi) : bi;
            const int rowbase = isctx ? (ML + b * TC + blk * 64) : (b * T + blk * 64);
            __syncthreads();
            for (int i = tid; i < 64 * 128; i += NTHR) { const int p = i >> 7, c = i & 127; const int tok = rowbase + (dir ? 63 - p : p);
                sk[i] = bf2f(Kb[(size_t)tok * 512 + h * 128 + c]);
                sq[i] = isctx ? 0.f : bf2f(Q[(size_t)tok * 512 + h * 128 + c]); }
            for (int i = tid; i < 64 * 32; i += NTHR) { const int p = i >> 5, c = i & 31; const int tok = rowbase + (dir ? 63 - p : p);
                sv[i] = bf2f(V[(size_t)tok * D + h * 256 + dvb * 32 + c]); }
            if (tid < 64) { const int tok = rowbase + (dir ? 63 - tid : tid);
                sg[2 * tid] = __expf(Gt[(size_t)tok * 16 + dir * 8 + h]); sg[2 * tid + 1] = __expf(logsigmoid_f(Gt[(size_t)tok * 16 + dir * 8 + 4 + h])); }
            __syncthreads();
            for (int p = 0; p < 64; ++p) {
                const float iv = sg[2 * p], fv = sg[2 * p + 1], vv = sv[p * 32 + j];
                float pn = 0.f, pd = 0.f;
#pragma unroll
                for (int d = 0; d < 8; ++d) { const float kk = sk[p * 128 + 8 * g + d], qq = sq[p * 128 + 8 * g + d];
                    Cst[d] = fv * Cst[d] + iv * kk * vv; nst[d] = fv * nst[d] + iv * kk;
                    pn += qq * Cst[d]; pd += qq * nst[d]; }
                if (!isctx) {
                    pn += __shfl_xor(pn, 1); pn += __shfl_xor(pn, 2); pn += __shfl_xor(pn, 4); pn += __shfl_xor(pn, 8);
                    pd += __shfl_xor(pd, 1); pd += __shfl_xor(pd, 2); pd += __shfl_xor(pd, 4); pd += __shfl_xor(pd, 8);
                    if (g == 0) { const int tok = rowbase + (dir ? 63 - p : p);
                        Hout[(size_t)tok * D + h * 256 + dvb * 32 + j] = (bf16)f2bf(pn / fmaxf(fabsf(pd), 1.0f)); }
                }
            }
        }
    }
}


namespace pg8 {
typedef short bf16x8 __attribute__((ext_vector_type(8)));
constexpr int BM = 256, BK = 64, HALF = 128, HTB = HALF * BK * 2, STAGE_BYTES = 8 * HTB, NXCD = 8, WGM = 8;
__host__ __device__ __forceinline__ int lds_byte(int r, int c) { const int st = (r >> 4) * 2 + (c >> 5), rr = r & 15, cc = c & 31, ob = rr * 64 + cc * 2; return st * 1024 + (ob ^ (((ob >> 9) & 1) << 5)); }
__host__ __device__ __forceinline__ void stage_rc(int b, int& R, int& C) { const int st = b / 1024, sb = b % 1024, swz = sb ^ (((sb >> 9) & 1) << 5); R = (st >> 1) * 16 + swz / 64; C = (st & 1) * 32 + (swz % 64) / 2; }
__host__ __device__ __forceinline__ int perm32(int rho) { const int n = rho >> 4, i = rho & 15; return 8 * (i >> 2) + 4 * n + (i & 3); }
struct Unit { int pm, pn; };
struct Gemm { const bf16* A; const bf16* Bt; int lda, ldb, K, mode;
    __device__ __forceinline__ size_t a_off(const Unit& u) const { return mode == 0 ? (size_t)u.pm * 256 * lda : (size_t)(u.pm & 15) * 256 * lda; }
    __device__ __forceinline__ size_t b_off(const Unit& u) const { return mode == 0 ? (size_t)u.pn * 256 * ldb : (size_t)((u.pm >> 4) * 1024 + u.pn * 256) * ldb; }
};
struct StaticOrder {
    int nM, nN, nwg, G, c;
    __device__ __forceinline__ void init(int nM_, int nN_, int G_, int c_) { nM = nM_; nN = nN_; nwg = nM * nN; G = G_; c = c_; }
    __device__ __forceinline__ bool next(int i, Unit& u) const {
        const long L = (long)i * G + c; if (L >= nwg) return false;
        int wgid = (int)L; { const int q = nwg / NXCD, r = nwg % NXCD, xcd = wgid % NXCD, off = wgid / NXCD; wgid = (xcd < r ? xcd * (q + 1) : r * (q + 1) + (xcd - r) * q) + off; }
        const int nig = WGM * nN, gid = wgid / nig, fm = gid * WGM, gsz = (nM - fm) < WGM ? (nM - fm) : WGM;
        u.pm = fm + ((wgid % nig) % gsz); u.pn = (wgid % nig) / gsz; return true;
    }
};
__device__ __forceinline__ unsigned cvt_pk_bf16(float lo, float hi) { unsigned r; asm volatile("v_cvt_pk_bf16_f32 %0, %1, %2" : "=v"(r) : "v"(lo), "v"(hi)); return r; }
__device__ __forceinline__ u32x4 pack8(const f32x4 v0, const f32x4 v1) { u32x4 w; w.x = cvt_pk_bf16(v0[0], v0[1]); w.y = cvt_pk_bf16(v0[2], v0[3]); w.z = cvt_pk_bf16(v1[0], v1[1]); w.w = cvt_pk_bf16(v1[2], v1[3]); return w; }

struct EpiF32 {
    static constexpr bool PERM = false;
    float* C; int ldc; const float* bias;
    __device__ __forceinline__ void operator()(const f32x4 (&acc)[2][2][4][2], const Unit& u, int wr, int wc, int fr, int fq) const {
        const int row0 = u.pm * BM + wr * 64 + fr, col0 = u.pn * BM + wc * 32 + 4 * fq;
        f32x4 bv[2][2];
#pragma unroll
        for (int bj = 0; bj < 2; ++bj)
#pragma unroll
            for (int n = 0; n < 2; ++n) bv[bj][n] = bias ? *(const f32x4*)(bias + col0 + bj * HALF + n * 16) : (f32x4){0.f, 0.f, 0.f, 0.f};
#pragma unroll
        for (int ai = 0; ai < 2; ++ai)
#pragma unroll
            for (int m = 0; m < 4; ++m) { float* rowp = C + (size_t)(row0 + ai * HALF + m * 16) * ldc + col0;
#pragma unroll
                for (int bj = 0; bj < 2; ++bj)
#pragma unroll
                    for (int n = 0; n < 2; ++n) *(f32x4*)(rowp + bj * HALF + n * 16) = acc[ai][bj][m][n] + bv[bj][n]; }
    }
};
struct EpiInProj {
    static constexpr bool PERM = true;
    bf16 *Q, *Kb, *V, *O; float* Gt; const float* bias;
    __device__ __forceinline__ void operator()(const f32x4 (&acc)[2][2][4][2], const Unit& u, int wr, int wc, int fr, int fq) const {
        const int pn = u.pn, pm = u.pm, row0 = pm * BM + wr * 64 + fr;
        if (pn == 12) {
            if (wc == 0 && fq < 2) {
                const f32x4 b0 = *(const f32x4*)(bias + 3072 + 8 * fq), b1 = *(const f32x4*)(bias + 3072 + 8 * fq + 4);
#pragma unroll
                for (int ai = 0; ai < 2; ++ai)
#pragma unroll
                    for (int m = 0; m < 4; ++m) { float* p = Gt + (size_t)(row0 + ai * HALF + m * 16) * 16 + 8 * fq;
                        *(f32x4*)p = acc[ai][0][m][0] + b0; *(f32x4*)(p + 4) = acc[ai][0][m][1] + b1; }
            }
            return;
        }
        if (pm >= 64 && (pn < 2 || pn >= 8)) return;
        bf16* base; int ldc, colt; float sc = 1.f;
        if (pn < 2) { base = Q; ldc = 512; colt = pn * 256; }
        else if (pn < 4) { base = Kb; ldc = 512; colt = (pn - 2) * 256; sc = 0.08838834764831845f; }
        else if (pn < 8) { base = V; ldc = 1024; colt = (pn - 4) * 256; }
        else { base = O; ldc = 1024; colt = (pn - 8) * 256; }
        const int col0 = colt + wc * 32 + 8 * fq, bcol0 = pn * BM + wc * 32 + 8 * fq;
        f32x4 bv[2][2];
#pragma unroll
        for (int bj = 0; bj < 2; ++bj)
#pragma unroll
            for (int n = 0; n < 2; ++n) bv[bj][n] = *(const f32x4*)(bias + bcol0 + bj * HALF + 4 * n);
#pragma unroll
        for (int ai = 0; ai < 2; ++ai)
#pragma unroll
            for (int m = 0; m < 4; ++m) { bf16* rowp = base + (size_t)(row0 + ai * HALF + m * 16) * ldc + col0;
#pragma unroll
                for (int bj = 0; bj < 2; ++bj) { const f32x4 v0 = (acc[ai][bj][m][0] + bv[bj][0]) * sc, v1 = (acc[ai][bj][m][1] + bv[bj][1]) * sc;
                    *(u32x4*)(rowp + bj * HALF) = pack8(v0, v1); } }
    }
};
struct EpiSeqMix {
    static constexpr bool PERM = true;
    bf16* PQ;
    __device__ __forceinline__ void operator()(const f32x4 (&acc)[2][2][4][2], const Unit& u, int wr, int wc, int fr, int fq) const {
        const int b = u.pm >> 4, rt = u.pm & 15;
        const int row0 = b * 2048 + (rt & 7) * 256 + wr * 64 + fr, col0 = (rt >> 3) * 1024 + u.pn * 256 + wc * 32 + 8 * fq;
#pragma unroll
        for (int ai = 0; ai < 2; ++ai)
#pragma unroll
            for (int m = 0; m < 4; ++m) { bf16* rowp = PQ + (size_t)(row0 + ai * HALF + m * 16) * 2048 + col0;
#pragma unroll
                for (int bj = 0; bj < 2; ++bj) *(u32x4*)(rowp + bj * HALF) = pack8(acc[ai][bj][m][0], acc[ai][bj][m][1]); }
    }
};
__device__ __forceinline__ float dpp_ror1(float v) { return __int_as_float(__builtin_amdgcn_update_dpp(0, __float_as_int(v), 0x121, 0xf, 0xf, false)); }
__device__ __forceinline__ float dpp_rol1(float v) { return __int_as_float(__builtin_amdgcn_update_dpp(0, __float_as_int(v), 0x12f, 0xf, 0xf, false)); }
struct EpiUpConv {
    static constexpr bool PERM = true;
    bf16* ACT; const float* cw; const float* cb;
    __device__ __forceinline__ void operator()(const f32x4 (&acc)[2][2][4][2], const Unit& u, int wr, int wc, int fr, int fq) const {
        const int f0 = u.pn * 128 + wc * 32 + 8 * fq, row0 = u.pm * BM + wr * 64 + fr;
        f32x4 w0[2], w1[2], w2[2], bb[2];
#pragma unroll
        for (int n = 0; n < 2; ++n) { w0[n] = *(const f32x4*)(cw + f0 + 4 * n); w1[n] = *(const f32x4*)(cw + FF + f0 + 4 * n); w2[n] = *(const f32x4*)(cw + 2 * FF + f0 + 4 * n); bb[n] = *(const f32x4*)(cb + f0 + 4 * n); }
        const bool first = (fr == 0), last = (fr == 15);
#pragma unroll
        for (int ai = 0; ai < 2; ++ai) {
            f32x4 res[4][2];
#pragma unroll
            for (int n = 0; n < 2; ++n) {
                f32x4 R[4], L[4];
#pragma unroll
                for (int m = 0; m < 4; ++m)
#pragma unroll
                    for (int e = 0; e < 4; ++e) { R[m][e] = dpp_ror1(acc[ai][1][m][n][e]); L[m][e] = dpp_rol1(acc[ai][1][m][n][e]); }
#pragma unroll
                for (int m = 0; m < 4; ++m)
#pragma unroll
                    for (int e = 0; e < 4; ++e) {
                        const float pv = first ? (m > 0 ? R[m > 0 ? m - 1 : 0][e] : 0.f) : R[m][e];
                        const float nv = last ? (m < 3 ? L[m < 3 ? m + 1 : 3][e] : 0.f) : L[m][e];
                        const float gc = pv * w0[n][e] + acc[ai][1][m][n][e] * w1[n][e] + nv * w2[n][e] + bb[n][e];
                        res[m][n][e] = gc * __builtin_amdgcn_rcpf(1.f + __expf(-gc)) * acc[ai][0][m][n][e];
                    }
            }
#pragma unroll
            for (int m = 0; m < 4; ++m) *(u32x4*)(ACT + (size_t)(row0 + ai * HALF + m * 16) * FF + f0) = pack8(res[m][0], res[m][1]);
        }
    }
};

template <class Epi, bool ALIGN_EPI = true>
__device__ __forceinline__ void gemm_phase(LAS unsigned char* lds, const Gemm g, const StaticOrder& S, const Epi& E) {
    const int tid = threadIdx.x, wid = __builtin_amdgcn_readfirstlane(tid >> 6), lane = tid & 63, wr = wid >> 2, wc = wid & 3, fr = lane & 15, fq = lane >> 4;
    const int K = g.K, nt = K / BK;
    unsigned voffA[2], voffB[2];
#pragma unroll
    for (int i = 0; i < 2; ++i) { int R, C; stage_rc(tid * 16 + i * 8192, R, C); const int Rb = Epi::PERM ? ((R & ~31) + perm32(R & 31)) : R;
        voffA[i] = (unsigned)(R * g.lda + C) * 2u; voffB[i] = (unsigned)(Rb * g.ldb + C) * 2u; }
    const size_t kstep = (size_t)(BK * 2);
    const size_t hstepA = (size_t)HALF * g.lda * 2, hstepB = (size_t)HALF * g.ldb * 2;
    const unsigned ldsw = (unsigned)wid * 1024u;
    const int aoff = lds_byte(wr * 64 + fr, fq * 8), boff = lds_byte(wc * 32 + fr, fq * 8);
#define PG8_SA(b, h) (((b) * 2 + (h)) * HTB)
#define PG8_SB(b, h) ((4 + (b) * 2 + (h)) * HTB)
#define PG8_STAGE(bufoff, gbase, voff) do { _Pragma("unroll") for (int _i = 0; _i < 2; ++_i) \
        __builtin_amdgcn_global_load_lds((const unsigned*)((const char*)(gbase) + (voff)[_i]), (LAS unsigned*)(lds + (bufoff) + ldsw + _i * 8192), 16, 0, 0); } while (0)
#define PG8_LDA(dst, b, h) do { _Pragma("unroll") for (int m = 0; m < 4; ++m) _Pragma("unroll") for (int k = 0; k < 2; ++k) dst[m][k] = *(const LAS bf16x8*)(lds + PG8_SA(b, h) + aoff + m * 2048 + k * 1024); } while (0)
#define PG8_LDB(dst, b, h) do { _Pragma("unroll") for (int n = 0; n < 2; ++n) _Pragma("unroll") for (int k = 0; k < 2; ++k) dst[n][k] = *(const LAS bf16x8*)(lds + PG8_SB(b, h) + boff + n * 2048 + k * 1024); } while (0)
#define PG8_MMA(ai, bj, At, Bt) do { __builtin_amdgcn_s_setprio(1); _Pragma("unroll") for (int m = 0; m < 4; ++m) _Pragma("unroll") for (int n = 0; n < 2; ++n) _Pragma("unroll") for (int k = 0; k < 2; ++k) \
        acc[ai][bj][m][n] = __builtin_amdgcn_mfma_f32_16x16x32_bf16(Bt[n][k], At[m][k], acc[ai][bj][m][n], 0, 0, 0); __builtin_amdgcn_s_setprio(0); } while (0)
#define PG8_WAIT_V(n) asm volatile("s_waitcnt vmcnt(" #n ")" ::: "memory")
#define PG8_WAIT_L(n) asm volatile("s_waitcnt lgkmcnt(" #n ")" ::: "memory")
#define PG8_BAR __builtin_amdgcn_s_barrier()
#define PG8_SCHED __builtin_amdgcn_sched_barrier(0)
    Unit cur, nxt; int ui = 0;
    if (!S.next(0, cur)) return;
    f32x4 acc[2][2][4][2];
#pragma unroll
    for (int a = 0; a < 2; ++a)
#pragma unroll
        for (int b = 0; b < 2; ++b)
#pragma unroll
            for (int m = 0; m < 4; ++m)
#pragma unroll
                for (int n = 0; n < 2; ++n) acc[a][b][m][n] = (f32x4){0.f, 0.f, 0.f, 0.f};
    bf16x8 At[4][2], B0[2][2], B1[2][2];
    const char* cA = (const char*)g.A + g.a_off(cur) * 2; const char* cB = (const char*)g.Bt + g.b_off(cur) * 2;
    PG8_STAGE(PG8_SB(0, 0), cB, voffB); PG8_STAGE(PG8_SB(0, 1), cB + hstepB, voffB); PG8_STAGE(PG8_SA(0, 0), cA, voffA); PG8_STAGE(PG8_SA(0, 1), cA + hstepA, voffA);
    if (wr == 1) PG8_BAR;
    PG8_WAIT_V(2); PG8_BAR;
    PG8_STAGE(PG8_SB(1, 0), cB + kstep, voffB); PG8_STAGE(PG8_SA(1, 0), cA + kstep, voffA); PG8_STAGE(PG8_SB(1, 1), cB + hstepB + kstep, voffB);
    PG8_WAIT_V(6); PG8_BAR;
    for (;;) {
        const bool has_next = S.next(ui + 1, nxt);
        const char* nA = has_next ? (const char*)g.A + g.a_off(nxt) * 2 : cA; const char* nB = has_next ? (const char*)g.Bt + g.b_off(nxt) * 2 : cB;
        for (int t = 0; t < nt; t += 2) {
            const bool last = (t == nt - 2);
            const char* a1 = cA + (size_t)(t + 1) * kstep;
            const char* a2 = last ? nA : cA + (size_t)(t + 2) * kstep; const char* b2 = last ? nB : cB + (size_t)(t + 2) * kstep;
            const char* a3 = a2 + kstep; const char* b3 = b2 + kstep;
            PG8_LDB(B0, 0, 0); PG8_LDB(B1, 0, 1); PG8_SCHED; PG8_LDA(At, 0, 0); PG8_STAGE(PG8_SA(1, 1), a1 + hstepA, voffA);
            PG8_WAIT_V(8); PG8_WAIT_L(0); PG8_BAR; PG8_MMA(0, 0, At, B0); PG8_MMA(0, 1, At, B1); PG8_BAR; PG8_SCHED;
            PG8_LDA(At, 0, 1); PG8_STAGE(PG8_SB(0, 0), b2, voffB); PG8_STAGE(PG8_SB(0, 1), b2 + hstepB, voffB); PG8_STAGE(PG8_SA(0, 0), a2, voffA);
            PG8_WAIT_V(8); PG8_WAIT_L(0); PG8_BAR; PG8_MMA(1, 0, At, B0); PG8_MMA(1, 1, At, B1); PG8_BAR; PG8_SCHED;
            PG8_LDB(B0, 1, 0); PG8_LDB(B1, 1, 1); PG8_SCHED; PG8_LDA(At, 1, 0); PG8_STAGE(PG8_SA(0, 1), a2 + hstepA, voffA);
            PG8_WAIT_V(8); PG8_WAIT_L(0); PG8_BAR; PG8_MMA(0, 0, At, B0); PG8_MMA(0, 1, At, B1); PG8_BAR; PG8_SCHED;
            PG8_LDA(At, 1, 1); PG8_STAGE(PG8_SB(1, 0), b3, voffB); PG8_STAGE(PG8_SB(1, 1), b3 + hstepB, voffB); PG8_STAGE(PG8_SA(1, 0), a3, voffA);
            PG8_WAIT_V(8); PG8_WAIT_L(0); PG8_BAR; PG8_MMA(1, 0, At, B0); PG8_MMA(1, 1, At, B1); PG8_BAR; PG8_SCHED;
        }
        if constexpr (ALIGN_EPI) { if (wr == 0) PG8_BAR; }
        E(acc, cur, wr, wc, fr, fq);
        if (!has_next) break;
#pragma unroll
        for (int a = 0; a < 2; ++a)
#pragma unroll
            for (int b = 0; b < 2; ++b)
#pragma unroll
                for (int m = 0; m < 4; ++m)
#pragma unroll
                    for (int n = 0; n < 2; ++n) acc[a][b][m][n] = (f32x4){0.f, 0.f, 0.f, 0.f};
        cur = nxt; cA = nA; cB = nB; ++ui;
        if constexpr (ALIGN_EPI) { if (wr == 1) PG8_BAR; }
    }
    PG8_WAIT_V(0);
    if constexpr (!ALIGN_EPI) { if (wr == 0) PG8_BAR; }
    PG8_BAR;
#undef PG8_SA
#undef PG8_SB
#undef PG8_STAGE
#undef PG8_LDA
#undef PG8_LDB
#undef PG8_MMA
#undef PG8_WAIT_V
#undef PG8_WAIT_L
#undef PG8_BAR
#undef PG8_SCHED
}
}

#ifndef FAST_GEMM
#define FAST_GEMM 1
#endif

__global__ void __launch_bounds__(NTHR, 2) mk_fwd(Args a) {
    extern __shared__ __attribute__((aligned(16))) unsigned char lds_raw[];
    LAS unsigned char* lds = (LAS unsigned char*)lds_raw;
    const int tid = threadIdx.x, lane = tid & 63, wave = __builtin_amdgcn_readfirstlane(tid >> 6), G = gridDim.x;
    const int lo = a.ph_lo, hi = a.ph_hi;
    unsigned char* ws = a.ws;
    const float* MOD0 = (const float*)(ws + WS_MOD); const float* MOD1 = MOD0 + 9 * 6144;
#define IN(k) (lo <= (k) && (k) < hi)
#define SEAM(k) do { if (IN(k) && IN((k) + 1)) { __threadfence(); cg::this_grid().sync(); } } while (0)

    if (IN(0)) { p0_prep(a, lds, tid, lane, wave, G); } SEAM(0);
    if (IN(1)) { p1_norm_mod(a, lane, wave, G); } SEAM(1);
#if FAST_GEMM
    if (IN(2)) { pg8::Gemm g{(const bf16*)(ws + WS_A), (const bf16*)(ws + WS_WIN), D, D, D, 0}; pg8::StaticOrder S; S.init(MALL / 256, NPROJ_PAD / 256, G, (int)blockIdx.x);
        pg8::EpiInProj E{(bf16*)(ws + WS_Q), (bf16*)(ws + WS_K), (bf16*)(ws + WS_V), (bf16*)(ws + WS_O), (float*)(ws + WS_G), a.in[15]};
        pg8::gemm_phase<pg8::EpiInProj>(lds, g, S, E); } SEAM(2);
#else
    if (IN(2)) { p2_inproj_simple(a, lds, tid, G); } SEAM(2);
#endif
    if (IN(3)) { p3_mlstm_simple(a, lds, tid, G); } SEAM(3);
    if (IN(4)) { p4_readout(a, lane, wave, G); } SEAM(4);
#if FAST_GEMM
    if (IN(5)) { pg8::Gemm g{(const bf16*)(ws + WS_Y), (const bf16*)(ws + WS_WOUT), D, D, D, 0}; pg8::StaticOrder S; S.init(ML / 256, D / 256, G, (int)blockIdx.x);
        pg8::EpiF32 E{(float*)(ws + WS_Y1), D, nullptr}; pg8::gemm_phase<pg8::EpiF32>(lds, g, S, E); } SEAM(5);
#else
    if (IN(5)) { gemm_simple_f32((const bf16*)(ws + WS_Y), D, (const bf16*)(ws + WS_WOUT), D, ML, D, D, (float*)(ws + WS_Y1), D, nullptr, lds, tid, G); } SEAM(5);
#endif
    if (IN(6)) { rowpass<1>((const float*)(ws + WS_Y1), a.in[0], a.out, MOD0 + 2 * D, a.in[7], a.in[8], MOD0 + 3 * D, MOD0 + 4 * D, (bf16*)(ws + WS_H2), lane, wave, G); } SEAM(6);
#if FAST_GEMM
    if (IN(7)) { pg8::Gemm g{(const bf16*)(ws + WS_H2), (const bf16*)(ws + WS_WUP), D, D, D, 0}; pg8::StaticOrder S; S.init(ML / 256, NUP / 256, G, (int)blockIdx.x);
        pg8::EpiUpConv E{(bf16*)(ws + WS_ACT), a.in[11], a.in[12]}; pg8::gemm_phase<pg8::EpiUpConv>(lds, g, S, E); } SEAM(7);
    if (IN(8)) { pg8::Gemm g{(const bf16*)(ws + WS_ACT), (const bf16*)(ws + WS_WDN), FF, FF, FF, 0}; pg8::StaticOrder S; S.init(ML / 256, D / 256, G, (int)blockIdx.x);
        pg8::EpiF32 E{(float*)(ws + WS_Y2), D, nullptr}; pg8::gemm_phase<pg8::EpiF32>(lds, g, S, E); } SEAM(8);
#else
    if (IN(7)) { p7_up_simple((const bf16*)(ws + WS_H2), (const bf16*)(ws + WS_WUP), a.in[11], a.in[12], (bf16*)(ws + WS_ACT), lds, tid, G); } SEAM(7);
    if (IN(8)) { gemm_simple_f32((const bf16*)(ws + WS_ACT), FF, (const bf16*)(ws + WS_WDN), FF, ML, D, FF, (float*)(ws + WS_Y2), D, nullptr, lds, tid, G); } SEAM(8);
#endif
    if (IN(9)) { rowpass_t((const float*)(ws + WS_Y2), a.out, a.out, MOD0 + 5 * D, a.in[9], a.in[6] + D, MOD1, MOD1 + D, (bf16*)(ws + WS_HT), lds, tid, lane, wave, G); } SEAM(9);
#if FAST_GEMM
    if (IN(10)) { pg8::Gemm g{(const bf16*)(ws + WS_DFT), (const bf16*)(ws + WS_HT), 2048, 2048, 2048, 1}; pg8::StaticOrder S; S.init(NB * 16, 4, G, (int)blockIdx.x);
        pg8::EpiSeqMix E{(bf16*)(ws + WS_PQ)}; pg8::gemm_phase<pg8::EpiSeqMix>(lds, g, S, E); } SEAM(10);
    if (IN(11)) { pg8::Gemm g{(const bf16*)(ws + WS_PQ), (const bf16*)(ws + WS_WCS), 2048, 2048, 2048, 0}; pg8::StaticOrder S; S.init(ML / 256, D / 256, G, (int)blockIdx.x);
        pg8::EpiF32 E{(float*)(ws + WS_Y3), D, a.in[19]}; pg8::gemm_phase<pg8::EpiF32>(lds, g, S, E); } SEAM(11);
#else
    if (IN(10)) { p10_seqmix_simple(a, lds, tid, G); } SEAM(10);
    if (IN(11)) { gemm_simple_f32((const bf16*)(ws + WS_PQ), 2048, (const bf16*)(ws + WS_WCS), 2048, ML, D, 2048, (float*)(ws + WS_Y3), D, a.in[19], lds, tid, G); } SEAM(11);
#endif
    if (IN(12)) { rowpass<1>((const float*)(ws + WS_Y3), a.out, a.out, MOD1 + 2 * D, a.in[7] + D, a.in[8] + D, MOD1 + 3 * D, MOD1 + 4 * D, (bf16*)(ws + WS_H2B), lane, wave, G); } SEAM(12);
#if FAST_GEMM
    if (IN(13)) { pg8::Gemm g{(const bf16*)(ws + WS_H2B), (const bf16*)(ws + WS_WUP) + (size_t)NUP * D, D, D, D, 0}; pg8::StaticOrder S; S.init(ML / 256, NUP / 256, G, (int)blockIdx.x);
        pg8::EpiUpConv E{(bf16*)(ws + WS_ACT1), a.in[11] + 3 * FF, a.in[12] + FF}; pg8::gemm_phase<pg8::EpiUpConv>(lds, g, S, E); } SEAM(13);
    if (IN(14)) { pg8::Gemm g{(const bf16*)(ws + WS_ACT1), (const bf16*)(ws + WS_WDN) + (size_t)D * FF, FF, FF, FF, 0}; pg8::StaticOrder S; S.init(ML / 256, D / 256, G, (int)blockIdx.x);
        pg8::EpiF32 E{(float*)(ws + WS_Y2B), D, nullptr}; pg8::gemm_phase<pg8::EpiF32>(lds, g, S, E); } SEAM(14);
#else
    if (IN(13)) { p7_up_simple((const bf16*)(ws + WS_H2B), (const bf16*)(ws + WS_WUP) + (size_t)NUP * D, a.in[11] + 3 * FF, a.in[12] + FF, (bf16*)(ws + WS_ACT1), lds, tid, G); } SEAM(13);
    if (IN(14)) { gemm_simple_f32((const bf16*)(ws + WS_ACT1), FF, (const bf16*)(ws + WS_WDN) + (size_t)D * FF, FF, ML, D, FF, (float*)(ws + WS_Y2B), D, nullptr, lds, tid, G); } SEAM(14);
#endif
    if (IN(15)) { rowpass<0>((const float*)(ws + WS_Y2B), a.out, a.out, MOD1 + 5 * D, a.in[9] + D, nullptr, nullptr, nullptr, nullptr, lane, wave, G); }
#undef IN
#undef SEAM
}

extern "C" void kernel_launch(void* const* d_in, const int* in_sizes, int n_in, void* d_out, int out_size, void* d_ws, size_t ws_size, hipStream_t stream) {
    static int grid = 0;
    if (grid == 0) {
        if (n_in != 20 || out_size != ML * D || ws_size < WS_END) { fprintf(stderr, "kernel_launch: unexpected shapes (n_in %d out %d ws %zu)\n", n_in, out_size, ws_size); grid = -1; return; }
        int dev = 0, cus = 0, per_cu = 0;
        (void)hipGetDevice(&dev); (void)hipDeviceGetAttribute(&cus, hipDeviceAttributeMultiprocessorCount, dev);
        (void)hipFuncSetAttribute((const void*)mk_fwd, hipFuncAttributeMaxDynamicSharedMemorySize, LDS_BYTES);
        (void)hipOccupancyMaxActiveBlocksPerMultiprocessor(&per_cu, (const void*)mk_fwd, NTHR, LDS_BYTES);
        if (per_cu < 1) { fprintf(stderr, "kernel_launch: occupancy query says %d blocks/CU\n", per_cu); per_cu = 1; }
        grid = cus * 1;
        (void)hipGetLastError();
    }
    if (grid < 0) return;
    (void)hipMemsetAsync((char*)d_ws + WS_CTL, 0, 1 * MiB, stream);
    Args a{};
    for (int i = 0; i < 20; ++i) a.in[i] = (const float*)d_in[i];
    a.out = (float*)d_out; a.ws = (unsigned char*)d_ws;
    if (MK_N_LAUNCHES == 1) {
        a.ph_lo = 0; a.ph_hi = NPH;
        void* args[] = {&a};
        hipError_t e = hipLaunchCooperativeKernel((const void*)mk_fwd, dim3(grid), dim3(NTHR), args, LDS_BYTES, stream);
        if (e != hipSuccess) fprintf(stderr, "cooperative launch failed: %s (grid %d)\n", hipGetErrorString(e), grid);
    } else {
        for (int p = 0; p < NPH; ++p) { a.ph_lo = p; a.ph_hi = p + 1;
            hipLaunchKernelGGL(mk_fwd, dim3(grid), dim3(NTHR), LDS_BYTES, stream, a); }
    }
}
```

```cpp
#include <hip/hip_runtime.h>
#include <hip/hip_cooperative_groups.h>
#include <cstdio>
#include <cstdint>
namespace cg = cooperative_groups;

#ifndef MK_N_LAUNCHES
#define MK_N_LAUNCHES 1
#endif

#define GAS __attribute__((address_space(1)))
#define LAS __attribute__((address_space(3)))
typedef unsigned short bf16;
typedef float f32x4 __attribute__((ext_vector_type(4)));
typedef unsigned u32x4 __attribute__((ext_vector_type(4)));
typedef unsigned u32x2 __attribute__((ext_vector_type(2)));

constexpr int D = 1024, NB = 8, T = 2048, TC = 256;
constexpr int ML = NB * T;
constexpr int MC = NB * TC;
constexpr int MALL = ML + MC;
constexpr int NH = 4, DK = 128, DV = 256;
constexpr int NPROJ = 3088, NPROJ_PAD = 3328;
constexpr int FF = 2816, NUP = 2 * FF;
constexpr float EPS = 1e-6f;
constexpr int NPH = 16;
constexpr int NWAVES = 8, NTHR = 512;

constexpr size_t MiB = 1u << 20;
constexpr size_t WS_CTL = 0;
constexpr size_t WS_MOD = 1 * MiB;
constexpr size_t WS_WIN = 2 * MiB;
constexpr size_t WS_WOUT = WS_WIN + (size_t)NPROJ_PAD * D * 2;
constexpr size_t WS_WUP = WS_WOUT + (size_t)D * D * 2;
constexpr size_t WS_WDN = WS_WUP + (size_t)2 * NUP * D * 2;
constexpr size_t WS_WCS = WS_WDN + (size_t)2 * D * FF * 2;
constexpr size_t WS_DFT = WS_WCS + (size_t)D * 2048 * 2;
constexpr size_t WS_A = WS_DFT + (size_t)4096 * 2048 * 2;
constexpr size_t WS_C = WS_A + (size_t)MALL * D * 2;
constexpr size_t WS_B = WS_C + (size_t)ML * D * 2;
constexpr size_t WS_Q = WS_B;
constexpr size_t WS_K = WS_Q + (size_t)ML * 512 * 2;
constexpr size_t WS_V = WS_K + (size_t)MALL * 512 * 2;
constexpr size_t WS_O = WS_V + (size_t)MALL * D * 2;
constexpr size_t WS_G = WS_O + (size_t)ML * D * 2;
constexpr size_t WS_END = WS_B + 104 * MiB;
static_assert(WS_G + (size_t)MALL * 16 * 4 <= WS_END, "region B");
static_assert(WS_END <= 256 * MiB, "workspace");
constexpr size_t WS_HF = WS_A;
constexpr size_t WS_HB = WS_C;
constexpr size_t WS_Y = WS_Q;
constexpr size_t WS_Y1 = WS_V;
constexpr size_t WS_H2 = WS_A;
constexpr size_t WS_ACT = WS_B;
constexpr size_t WS_Y2 = WS_A;
constexpr size_t WS_HT = WS_B;
constexpr size_t WS_PQ = WS_B + 32 * MiB;
constexpr size_t WS_Y3 = WS_A;
constexpr size_t WS_H2B = WS_B + 72 * MiB;
constexpr size_t WS_ACT1 = WS_A;
constexpr size_t WS_Y2B = WS_B + 24 * MiB;
static_assert(WS_V + (size_t)ML * D * 4 <= WS_G, "y1 overlay");
static_assert(WS_ACT1 + (size_t)ML * FF * 2 <= WS_H2B && WS_ACT1 + (size_t)ML * FF * 2 <= WS_Y2B, "layer-1 overlays");
static_assert(WS_Y2B + (size_t)ML * D * 4 <= WS_END && WS_H2B + (size_t)ML * D * 2 <= WS_END && WS_PQ + (size_t)ML * 2048 * 2 <= WS_END, "layer-1 overlays");

constexpr int LDS_BYTES = 147456;

__device__ __forceinline__ float bf2f(unsigned v) { return __uint_as_float(v << 16); }
__device__ __forceinline__ unsigned f2bf(float f) { unsigned u = __float_as_uint(f); return (u + 0x7fffu + ((u >> 16) & 1u)) >> 16; }
__device__ __forceinline__ unsigned pk2(float lo, float hi) { return f2bf(lo) | (f2bf(hi) << 16); }
__device__ __forceinline__ float silu_f(float v) { return v / (1.f + __expf(-v)); }
__device__ __forceinline__ float sigmoid_f(float v) { return 1.f / (1.f + __expf(-v)); }
__device__ __forceinline__ float logsigmoid_f(float v) { return fminf(v, 0.f) - log1pf(__expf(-fabsf(v))); }
__device__ __forceinline__ float wave_sum(float v) {
#pragma unroll
    for (int o = 1; o < 64; o <<= 1) v += __shfl_xor(v, o);
    return v;
}

struct Args { const float* in[20]; float* out; unsigned char* ws; int ph_lo, ph_hi; };

template <int MODE>
__device__ __forceinline__ void p0_transpose_item(const float* W, int K, int N, bf16* WT, LAS float* scr, int item, int nblk, int lane) {
    const int kb = item / nblk, nb = item % nblk, k0 = 64 * kb, n0 = 32 * nb;
#pragma unroll 8
    for (int i = 0; i < 32; ++i) { const int kk = 2 * i + (lane >> 5); const int n = n0 + (lane & 31);
        scr[kk * 33 + (lane & 31)] = (n < N) ? W[(size_t)(k0 + kk) * N + n] : 0.f; }
    asm volatile("s_waitcnt lgkmcnt(0)" ::: "memory");
    const int c = lane & 7;
#pragma unroll
    for (int j = 0; j < 4; ++j) { const int nl = (lane >> 3) + 8 * j; const LAS float* s = scr + (8 * c) * 33 + nl;
        u32x4 o; o.x = pk2(s[0 * 33], s[1 * 33]); o.y = pk2(s[2 * 33], s[3 * 33]); o.z = pk2(s[4 * 33], s[5 * 33]); o.w = pk2(s[6 * 33], s[7 * 33]);
        int n = n0 + nl, dr = n;
        if (MODE == 1) { const int isg = n >= FF ? 1 : 0; const int jj = n - isg * FF; dr = (jj >> 7) * 256 + isg * 128 + (jj & 127); }
        *(u32x4*)(WT + (size_t)dr * K + k0 + 8 * c) = o; }
    asm volatile("s_waitcnt lgkmcnt(0)" ::: "memory");
}

__device__ __forceinline__ void p0_prep(const Args& a, LAS unsigned char* lds, int tid, int lane, int wave, int G) {
    unsigned char* ws = a.ws;
    {
        LAS float* scr = (LAS float*)(lds + wave * 16384);
        const int gw = blockIdx.x * NWAVES + wave, NGW = G * NWAVES;
        constexpr int I_IN = 16 * (NPROJ_PAD / 32), I_OUT = 16 * 32, I_UP = 16 * (NUP / 32), I_DN = (FF / 64) * 32;
        constexpr int NIT = I_IN + I_OUT + 2 * I_UP + 2 * I_DN;
        for (int it = gw; it < NIT; it += NGW) {
            int r = it;
            if (r < I_IN) { p0_transpose_item<0>(a.in[14], D, NPROJ, (bf16*)(ws + WS_WIN), scr, r, NPROJ_PAD / 32, lane); continue; } r -= I_IN;
            if (r < I_OUT) { p0_transpose_item<0>(a.in[17], D, D, (bf16*)(ws + WS_WOUT), scr, r, 32, lane); continue; } r -= I_OUT;
            if (r < I_UP) { p0_transpose_item<1>(a.in[10], D, NUP, (bf16*)(ws + WS_WUP), scr, r, NUP / 32, lane); continue; } r -= I_UP;
            if (r < I_UP) { p0_transpose_item<1>(a.in[10] + (size_t)D * NUP, D, NUP, (bf16*)(ws + WS_WUP) + (size_t)NUP * D, scr, r, NUP / 32, lane); continue; } r -= I_UP;
            if (r < I_DN) { p0_transpose_item<0>(a.in[13], FF, D, (bf16*)(ws + WS_WDN), scr, r, 32, lane); continue; } r -= I_DN;
            p0_transpose_item<0>(a.in[13] + (size_t)FF * D, FF, D, (bf16*)(ws + WS_WDN) + (size_t)D * FF, scr, r, 32, lane);
        }
    }
    __syncthreads();
    LAS float* tab = (LAS float*)(lds + 131072);
    for (int i = tid; i < 2048; i += NTHR) tab[i] = cospif((float)i * (1.0f / 1024.0f));
    __syncthreads();
    {
        bf16* DF = (bf16*)(ws + WS_DFT);
        const int total = 4096 * 256;
        for (int idx = blockIdx.x * NTHR + tid; idx < total; idx += G * NTHR) {
            const int r = idx >> 8, t0 = (idx & 255) * 8, tp = r & 2047, sh = (r >> 11) ? 512 : 0;
            float v[8];
#pragma unroll
            for (int j = 0; j < 8; ++j) v[j] = tab[(tp * (t0 + j) + sh) & 2047] * (1.0f / 512.0f);
            u32x4 o; o.x = pk2(v[0], v[1]); o.y = pk2(v[2], v[3]); o.z = pk2(v[4], v[5]); o.w = pk2(v[6], v[7]);
            *(u32x4*)(DF + (size_t)r * 2048 + t0) = o;
        }
    }
    {
        const float* W = a.in[18]; bf16* WCS = (bf16*)(ws + WS_WCS);
        LAS float* wt = (LAS float*)lds;
        for (int it = blockIdx.x; it < 8 * 16; it += G) {
            const int g = it >> 4, n0 = (it & 15) * 64;
            __syncthreads();
            for (int i = tid; i < 128 * 64; i += NTHR) wt[i] = W[(size_t)(g * 128 + (i >> 6)) * D + n0 + (i & 63)];
            __syncthreads();
            const int nl = tid >> 3, cgp = tid & 7;
            float ac[16], as[16];
#pragma unroll
            for (int j = 0; j < 16; ++j) { ac[j] = 0.f; as[j] = 0.f; }
            for (int cp = 0; cp < 128; ++cp) {
                const float w = wt[cp * 64 + nl];
#pragma unroll
                for (int j = 0; j < 16; ++j) { const int c = 16 * cgp + j; const int ph = (c * cp) & 127;
                    ac[j] += tab[ph * 16] * w; as[j] += tab[((ph * 16) + 1536) & 2047] * w; }
            }
            bf16* dst = WCS + (size_t)(n0 + nl) * 2048 + g * 128 + 16 * cgp;
            u32x4 o0, o1;
            o0.x = pk2(ac[0], ac[1]); o0.y = pk2(ac[2], ac[3]); o0.z = pk2(ac[4], ac[5]); o0.w = pk2(ac[6], ac[7]);
            o1.x = pk2(ac[8], ac[9]); o1.y = pk2(ac[10], ac[11]); o1.z = pk2(ac[12], ac[13]); o1.w = pk2(ac[14], ac[15]);
            *(u32x4*)dst = o0; *(u32x4*)(dst + 8) = o1;
            o0.x = pk2(as[0], as[1]); o0.y = pk2(as[2], as[3]); o0.z = pk2(as[4], as[5]); o0.w = pk2(as[6], as[7]);
            o1.x = pk2(as[8], as[9]); o1.y = pk2(as[10], as[11]); o1.z = pk2(as[12], as[13]); o1.w = pk2(as[14], as[15]);
            *(u32x4*)(dst + 1024) = o0; *(u32x4*)(dst + 1024 + 8) = o1;
        }
    }
    __syncthreads();
    {
        LAS float* sc = (LAS float*)lds;
        LAS float* red = (LAS float*)(lds + 40960);
        for (int i = tid; i < 9 * 1024; i += NTHR) { const float v = (i < 8 * 1024) ? a.in[1][i] : a.in[3][i - 8 * 1024]; sc[i] = silu_f(v); }
        __syncthreads();
        float* MOD = (float*)(ws + WS_MOD);
        for (int it = blockIdx.x; it < 2 * 96; it += G) {
            const int l = it / 96, c0 = (it % 96) * 64;
            const float* Wl = a.in[4] + (size_t)l * D * 6144 + c0 + lane;
            float acc[9];
#pragma unroll
            for (int r = 0; r < 9; ++r) acc[r] = 0.f;
            const int kb = wave * 128;
#pragma unroll 4
            for (int k = 0; k < 128; ++k) { const float w = Wl[(size_t)(kb + k) * 6144];
#pragma unroll
                for (int r = 0; r < 9; ++r) acc[r] += sc[r * 1024 + kb + k] * w; }
#pragma unroll
            for (int r = 0; r < 9; ++r) red[(wave * 9 + r) * 64 + lane] = acc[r];
            __syncthreads();
            for (int i = tid; i < 9 * 64; i += NTHR) { float s = 0.f;
#pragma unroll
                for (int w = 0; w < 8; ++w) s += red[w * 576 + i];
                const int r = i >> 6, cl = i & 63;
                MOD[((size_t)l * 9 + r) * 6144 + c0 + cl] = s + a.in[5][(size_t)l * 6144 + c0 + cl]; }
            __syncthreads();
        }
    }
}

__device__ __forceinline__ void load_row_f32(const float* p, int lane, f32x4 (&v)[4]) {
#pragma unroll
    for (int j = 0; j < 4; ++j) v[j] = *(const f32x4*)(p + 4 * lane + 256 * j);
}
__device__ __forceinline__ float row_sumsq(const f32x4 (&v)[4]) {
    float s = 0.f;
#pragma unroll
    for (int j = 0; j < 4; ++j) s += (v[j].x * v[j].x + v[j].y * v[j].y) + (v[j].z * v[j].z + v[j].w * v[j].w);
    return wave_sum(s);
}

__device__ __forceinline__ void p1_norm_mod(const Args& a, int lane, int wave, int G) {
    const float* MOD = (const float*)(a.ws + WS_MOD);
    bf16* A = (bf16*)(a.ws + WS_A);
    const float* g = a.in[6];
    const int gw = blockIdx.x * NWAVES + wave, NGW = G * NWAVES;
    for (int m = gw; m < MALL; m += NGW) {
        const float* xr = (m < ML) ? a.in[0] + (size_t)m * D : a.in[2] + (size_t)(m - ML) * D;
        const int mr = (m < ML) ? (m >> 11) : 8;
        const float* sh = MOD + (size_t)mr * 6144, * sc = sh + D;
        f32x4 v[4]; load_row_f32(xr, lane, v);
        const float rs = rsqrtf(row_sumsq(v) * (1.f / D) + EPS);
#pragma unroll
        for (int j = 0; j < 4; ++j) { const int c = 4 * lane + 256 * j;
            const f32x4 gg = *(const f32x4*)(g + c), s1 = *(const f32x4*)(sc + c), s0 = *(const f32x4*)(sh + c);
            const f32x4 h = v[j] * rs * gg * (1.f + s1) + s0;
            u32x2 o; o.x = pk2(h.x, h.y); o.y = pk2(h.z, h.w);
            *(u32x2*)(A + (size_t)m * D + c) = o; }
    }
}

__device__ __forceinline__ void p4_readout(const Args& a, int lane, int wave, int G) {
    const bf16* HF = (const bf16*)(a.ws + WS_HF); const bf16* HB = (const bf16*)(a.ws + WS_HB); const bf16* O = (const bf16*)(a.ws + WS_O);
    bf16* Y = (bf16*)(a.ws + WS_Y); const float* ng = a.in[16];
    const int gw = blockIdx.x * NWAVES + wave, NGW = G * NWAVES;
    for (int m = gw; m < ML; m += NGW) {
        const size_t off = (size_t)m * D + 16 * lane;
        const u32x4 f0 = *(const u32x4*)(HF + off), f1 = *(const u32x4*)(HF + off + 8);
        const u32x4 b0 = *(const u32x4*)(HB + off), b1 = *(const u32x4*)(HB + off + 8);
        const u32x4 o0 = *(const u32x4*)(O + off), o1 = *(const u32x4*)(O + off + 8);
        float h[16], og[16];
        const unsigned fw[8] = {f0.x, f0.y, f0.z, f0.w, f1.x, f1.y, f1.z, f1.w};
        const unsigned bw[8] = {b0.x, b0.y, b0.z, b0.w, b1.x, b1.y, b1.z, b1.w};
        const unsigned ow[8] = {o0.x, o0.y, o0.z, o0.w, o1.x, o1.y, o1.z, o1.w};
        float ss = 0.f;
#pragma unroll
        for (int j = 0; j < 8; ++j) {
            h[2 * j] = bf2f(fw[j] & 0xffffu) + bf2f(bw[j] & 0xffffu); h[2 * j + 1] = bf2f(fw[j] >> 16) + bf2f(bw[j] >> 16);
            og[2 * j] = bf2f(ow[j] & 0xffffu); og[2 * j + 1] = bf2f(ow[j] >> 16);
            ss += h[2 * j] * h[2 * j] + h[2 * j + 1] * h[2 * j + 1]; }
        ss += __shfl_xor(ss, 1); ss += __shfl_xor(ss, 2); ss += __shfl_xor(ss, 4); ss += __shfl_xor(ss, 8);
        const float rs = rsqrtf(ss * (1.f / DV) + EPS);
        unsigned w[8];
#pragma unroll
        for (int j = 0; j < 8; ++j) {
            const float y0 = h[2 * j] * rs * ng[16 * lane + 2 * j] * sigmoid_f(og[2 * j]);
            const float y1 = h[2 * j + 1] * rs * ng[16 * lane + 2 * j + 1] * sigmoid_f(og[2 * j + 1]);
            w[j] = pk2(y0, y1); }
        *(u32x4*)(Y + off) = (u32x4){w[0], w[1], w[2], w[3]}; *(u32x4*)(Y + off + 8) = (u32x4){w[4], w[5], w[6], w[7]};
    }
}

template <int NEXT>
__device__ __forceinline__ void rowpass(const float* Y, const float* xin, float* xout, const float* gate  , const float* post_g,
                                        const float* ng, const float* shp, const float* scp, bf16* Hout, int lane, int wave, int G) {
    const int gw = blockIdx.x * NWAVES + wave, NGW = G * NWAVES;
    for (int m = gw; m < ML; m += NGW) {
        const int b = m >> 11;
        f32x4 y[4], x[4]; load_row_f32(Y + (size_t)m * D, lane, y); load_row_f32(xin + (size_t)m * D, lane, x);
        const float rs = rsqrtf(row_sumsq(y) * (1.f / D) + EPS);
#pragma unroll
        for (int j = 0; j < 4; ++j) { const int c = 4 * lane + 256 * j;
            const f32x4 gt = *(const f32x4*)(gate + (size_t)b * 6144 + c), pg = *(const f32x4*)(post_g + c);
            x[j] = x[j] + gt * (y[j] * rs * pg);
            *(f32x4*)(xout + (size_t)m * D + c) = x[j]; }
        if (NEXT == 1) {
            const float rs2 = rsqrtf(row_sumsq(x) * (1.f / D) + EPS);
#pragma unroll
            for (int j = 0; j < 4; ++j) { const int c = 4 * lane + 256 * j;
                const f32x4 gg = *(const f32x4*)(ng + c), s1 = *(const f32x4*)(scp + (size_t)b * 6144 + c), s0 = *(const f32x4*)(shp + (size_t)b * 6144 + c);
                const f32x4 h = x[j] * rs2 * gg * (1.f + s1) + s0;
                u32x2 o; o.x = pk2(h.x, h.y); o.y = pk2(h.z, h.w);
                *(u32x2*)(Hout + (size_t)m * D + c) = o; }
        }
    }
}
__device__ __forceinline__ void rowpass_t(const float* Y, const float* xin, float* xout, const float* gate, const float* post_g,
                                          const float* ng, const float* shp, const float* scp, bf16* HT, LAS unsigned char* lds, int tid, int lane, int wave, int G) {
    constexpr int PITCH = 1024 + 8;
    LAS bf16* tile = (LAS bf16*)lds;
    for (int it = blockIdx.x; it < ML / 64; it += G) {
        const int m0 = it * 64, b = m0 >> 11, t0 = m0 & 2047;
        __syncthreads();
        for (int rr = 0; rr < 8; ++rr) {
            const int r = wave * 8 + rr, m = m0 + r;
            f32x4 y[4], x[4]; load_row_f32(Y + (size_t)m * D, lane, y); load_row_f32(xin + (size_t)m * D, lane, x);
            const float rs = rsqrtf(row_sumsq(y) * (1.f / D) + EPS);
#pragma unroll
            for (int j = 0; j < 4; ++j) { const int c = 4 * lane + 256 * j;
                const f32x4 gt = *(const f32x4*)(gate + (size_t)b * 6144 + c), pg = *(const f32x4*)(post_g + c);
                x[j] = x[j] + gt * (y[j] * rs * pg);
                *(f32x4*)(xout + (size_t)m * D + c) = x[j]; }
            const float rs2 = rsqrtf(row_sumsq(x) * (1.f / D) + EPS);
#pragma unroll
            for (int j = 0; j < 4; ++j) { const int c = 4 * lane + 256 * j;
                const f32x4 gg = *(const f32x4*)(ng + c), s1 = *(const f32x4*)(scp + (size_t)b * 6144 + c), s0 = *(const f32x4*)(shp + (size_t)b * 6144 + c);
                const f32x4 h = x[j] * rs2 * gg * (1.f + s1) + s0;
                u32x2 o; o.x = pk2(h.x, h.y); o.y = pk2(h.z, h.w);
                *(LAS u32x2*)(tile + r * PITCH + c) = o; }
        }
        __syncthreads();
        unsigned lo[32], hi[32];
#pragma unroll
        for (int t = 0; t < 64; t += 2) {
            const unsigned w0 = *(const LAS unsigned*)(tile + t * PITCH + 2 * tid), w1 = *(const LAS unsigned*)(tile + (t + 1) * PITCH + 2 * tid);
            lo[t >> 1] = (w0 & 0xffffu) | (w1 << 16); hi[t >> 1] = (w0 >> 16) | (w1 & 0xffff0000u); }
        bf16* d0 = HT + ((size_t)b * D + 2 * tid) * T + t0; bf16* d1 = d0 + T;
#pragma unroll
        for (int q = 0; q < 8; ++q) { *(u32x4*)(d0 + 8 * q) = (u32x4){lo[4 * q], lo[4 * q + 1], lo[4 * q + 2], lo[4 * q + 3]};
                                      *(u32x4*)(d1 + 8 * q) = (u32x4){hi[4 * q], hi[4 * q + 1], hi[4 * q + 2], hi[4 * q + 3]}; }
    }
}

__device__ __forceinline__ void ngemm_tile(const bf16* A, int lda, const bf16* Bt, int ldb, int K, LAS float* sA, LAS float* sB, int tid, float (&acc)[4][4]) {
#pragma unroll
    for (int i = 0; i < 4; ++i)
#pragma unroll
        for (int j = 0; j < 4; ++j) acc[i][j] = 0.f;
    const int ty = tid >> 4, tx = tid & 15;
    for (int k0 = 0; k0 < K; k0 += 32) {
        { const u32x4 v = *(const u32x4*)(A + (size_t)(tid >> 2) * lda + k0 + (tid & 3) * 8);
          LAS float* d = sA + (tid >> 2) * 33 + (tid & 3) * 8;
          d[0] = bf2f(v.x & 0xffffu); d[1] = bf2f(v.x >> 16); d[2] = bf2f(v.y & 0xffffu); d[3] = bf2f(v.y >> 16);
          d[4] = bf2f(v.z & 0xffffu); d[5] = bf2f(v.z >> 16); d[6] = bf2f(v.w & 0xffffu); d[7] = bf2f(v.w >> 16); }
        { const u32x2 v = *(const u32x2*)(Bt + (size_t)(tid >> 3) * ldb + k0 + (tid & 7) * 4);
          LAS float* d = sB + (tid >> 3) * 33 + (tid & 7) * 4;
          d[0] = bf2f(v.x & 0xffffu); d[1] = bf2f(v.x >> 16); d[2] = bf2f(v.y & 0xffffu); d[3] = bf2f(v.y >> 16); }
        __syncthreads();
#pragma unroll 8
        for (int k = 0; k < 32; ++k) {
            float av[4], bv[4];
#pragma unroll
            for (int i = 0; i < 4; ++i) { av[i] = sA[(4 * ty + i) * 33 + k]; bv[i] = sB[(4 * tx + i) * 33 + k]; }
#pragma unroll
            for (int i = 0; i < 4; ++i)
#pragma unroll
                for (int j = 0; j < 4; ++j) acc[i][j] += av[i] * bv[j];
        }
        __syncthreads();
    }
}

__device__ __forceinline__ void p2_inproj_simple(const Args& a, LAS unsigned char* lds, int tid, int G) {
    LAS float* sA = (LAS float*)lds; LAS float* sB = sA + 128 * 33;
    const bf16* A = (const bf16*)(a.ws + WS_A); const bf16* W = (const bf16*)(a.ws + WS_WIN);
    bf16* Q = (bf16*)(a.ws + WS_Q); bf16* Kb = (bf16*)(a.ws + WS_K); bf16* V = (bf16*)(a.ws + WS_V); bf16* O = (bf16*)(a.ws + WS_O); float* Gt = (float*)(a.ws + WS_G);
    const float* bias = a.in[15];
    constexpr int NCB = 49;
    const int ty = tid >> 4, tx = tid & 15;
    for (int it = blockIdx.x; it < (MALL / 128) * NCB; it += G) {
        const int rt = it / NCB, cb = it % NCB, row0 = rt * 128, col0 = cb * 64;
        float acc[4][4];
        ngemm_tile(A + (size_t)row0 * D, D, W + (size_t)col0 * D, D, D, sA, sB, tid, acc);
#pragma unroll
        for (int i = 0; i < 4; ++i)
#pragma unroll
            for (int j = 0; j < 4; ++j) {
                const int r = row0 + 4 * ty + i, c = col0 + 4 * tx + j;
                if (c >= NPROJ) continue;
                const float v = acc[i][j] + bias[c];
                if (c < 512) { if (r < ML) Q[(size_t)r * 512 + c] = (bf16)f2bf(v); }
                else if (c < 1024) Kb[(size_t)r * 512 + (c - 512)] = (bf16)f2bf(v * 0.08838834764831845f);
                else if (c < 2048) V[(size_t)r * D + (c - 1024)] = (bf16)f2bf(v);
                else if (c < 3072) { if (r < ML) O[(size_t)r * D + (c - 2048)] = (bf16)f2bf(v); }
                else Gt[(size_t)r * 16 + (c - 3072)] = v;
            }
    }
}

__device__ __forceinline__ void gemm_simple_f32(const bf16* A, int lda, const bf16* Bt, int ldb, int M, int N, int K, float* C, int ldc, const float* bias, LAS unsigned char* lds, int tid, int G) {
    LAS float* sA = (LAS float*)lds; LAS float* sB = sA + 128 * 33;
    const int ty = tid >> 4, tx = tid & 15, ncb = N / 64;
    for (int it = blockIdx.x; it < (M / 128) * ncb; it += G) {
        const int rt = it / ncb, cb = it % ncb, row0 = rt * 128, col0 = cb * 64;
        float acc[4][4];
        ngemm_tile(A + (size_t)row0 * lda, lda, Bt + (size_t)col0 * ldb, ldb, K, sA, sB, tid, acc);
#pragma unroll
        for (int i = 0; i < 4; ++i) { f32x4 o = {acc[i][0], acc[i][1], acc[i][2], acc[i][3]};
            if (bias) o = o + *(const f32x4*)(bias + col0 + 4 * tx);
            *(f32x4*)(C + (size_t)(row0 + 4 * ty + i) * ldc + col0 + 4 * tx) = o; }
    }
}

__device__ __forceinline__ void p7_up_simple(const bf16* A, const bf16* W  , const float* cw  , const float* cb, bf16* ACT, LAS unsigned char* lds, int tid, int G) {
    LAS float* sA = (LAS float*)lds; LAS float* sB = sA + 128 * 33; LAS float* gs = sB + 64 * 33;
    const int ty = tid >> 4, tx = tid & 15;
    constexpr int NCB = FF / 64;
    for (int it = blockIdx.x; it < (ML / 128) * NCB; it += G) {
        const int rt = it / NCB, jb = it % NCB, row0 = rt * 128, j0 = jb * 64;
        const int wrow = (jb >> 1) * 256 + (jb & 1) * 64;
        float u[4][4], g[4][4];
        ngemm_tile(A + (size_t)row0 * D, D, W + (size_t)wrow * D, D, D, sA, sB, tid, u);
        ngemm_tile(A + (size_t)row0 * D, D, W + (size_t)(wrow + 128) * D, D, D, sA, sB, tid, g);
#pragma unroll
        for (int i = 0; i < 4; ++i)
#pragma unroll
            for (int j = 0; j < 4; ++j) gs[(4 * ty + i) * 65 + 4 * tx + j] = g[i][j];
        __syncthreads();
#pragma unroll
        for (int i = 0; i < 4; ++i)
#pragma unroll
            for (int j = 0; j < 4; ++j) {
                const int rl = 4 * ty + i, cl = 4 * tx + j, f = j0 + cl;
                const float gm = (rl & 63) ? gs[(rl - 1) * 65 + cl] : 0.f, gp = ((rl & 63) != 63) ? gs[(rl + 1) * 65 + cl] : 0.f;
                const float gc = gm * cw[f] + g[i][j] * cw[FF + f] + gp * cw[2 * FF + f] + cb[f];
                ACT[(size_t)(row0 + rl) * FF + f] = (bf16)f2bf(silu_f(gc) * u[i][j]);
            }
        __syncthreads();
    }
}

__device__ __forceinline__ void p10_seqmix_simple(const Args& a, LAS unsigned char* lds, int tid, int G) {
    LAS float* sA = (LAS float*)lds; LAS float* sB = sA + 128 * 33;
    const bf16* DF = (const bf16*)(a.ws + WS_DFT); const bf16* HT = (const bf16*)(a.ws + WS_HT); bf16* PQ = (bf16*)(a.ws + WS_PQ);
    const int ty = tid >> 4, tx = tid & 15;
    for (int it = blockIdx.x; it < 8 * 32 * 16; it += G) {
        const int b = it >> 9, rt = (it >> 4) & 31, cbk = it & 15, r0 = rt * 128, c0 = cbk * 64;
        float acc[4][4];
        ngemm_tile(DF + (size_t)r0 * 2048, 2048, HT + ((size_t)b * D + c0) * T, T, 2048, sA, sB, tid, acc);
        const int kind = r0 >> 11, tp0 = r0 & 2047;
#pragma unroll
        for (int i = 0; i < 4; ++i) { u32x2 o; o.x = pk2(acc[i][0], acc[i][1]); o.y = pk2(acc[i][2], acc[i][3]);
            *(u32x2*)(PQ + (size_t)(b * 2048 + tp0 + 4 * ty + i) * 2048 + kind * 1024 + c0 + 4 * tx) = o; }
    }
}

__device__ __forceinline__ void p3_mlstm_simple(const Args& a, LAS unsigned char* lds, int tid, int G) {
    const bf16* Q = (const bf16*)(a.ws + WS_Q); const bf16* Kb = (const bf16*)(a.ws + WS_K); const bf16* V = (const bf16*)(a.ws + WS_V); const float* Gt = (const float*)(a.ws + WS_G);
    LAS float* sq = (LAS float*)lds;
    LAS float* sk = sq + 64 * 128;
    LAS float* sv = sk + 64 * 128;
    LAS float* sg = sv + 64 * 32;
    const int j = tid >> 4, g = tid & 15;
    for (int it = blockIdx.x; it < 64 * 8; it += G) {
        const int bh = it >> 4, dir = (it >> 3) & 1, dvb = it & 7, b = bh >> 2, h = bh & 3;
        bf16* Hout = (bf16*)(a.ws + (dir ? WS_HB : WS_HF));
        float Cst[8], nst[8];
#pragma unroll
        for (int d = 0; d < 8; ++d) { Cst[d] = 0.f; nst[d] = 0.f; }
        for (int sb = 0; sb < 36; ++sb) {
            const bool isctx = sb < 4;
            const int nblk = isctx ? 4 : 32, bi = isctx ? sb : sb - 4;
            const int blk = dir ? (nblk - 1 - bi) : bi;
            const int rowbase = isctx ? (ML + b * TC + blk * 64) : (b * T + blk * 64);
            __syncthreads();
            for (int i = tid; i < 64 * 128; i += NTHR) { const int p = i >> 7, c = i & 127; const int tok = rowbase + (dir ? 63 - p : p);
                sk[i] = bf2f(Kb[(size_t)tok * 512 + h * 128 + c]);
                sq[i] = isctx ? 0.f : bf2f(Q[(size_t)tok * 512 + h * 128 + c]); }
            for (int i = tid; i < 64 * 32; i += NTHR) { const int p = i >> 5, c = i & 31; const int tok = rowbase + (dir ? 63 - p : p);
                sv[i] = bf2f(V[(size_t)tok * D + h * 256 + dvb * 32 + c]); }
            if (tid < 64) { const int tok = rowbase + (dir ? 63 - tid : tid);
                sg[2 * tid] = __expf(Gt[(size_t)tok * 16 + dir * 8 + h]); sg[2 * tid + 1] = __expf(logsigmoid_f(Gt[(size_t)tok * 16 + dir * 8 + 4 + h])); }
            __syncthreads();
            for (int p = 0; p < 64; ++p) {
                const float iv = sg[2 * p], fv = sg[2 * p + 1], vv = sv[p * 32 + j];
                float pn = 0.f, pd = 0.f;
#pragma unroll
                for (int d = 0; d < 8; ++d) { const float kk = sk[p * 128 + 8 * g + d], qq = sq[p * 128 + 8 * g + d];
                    Cst[d] = fv * Cst[d] + iv * kk * vv; nst[d] = fv * nst[d] + iv * kk;
                    pn += qq * Cst[d]; pd += qq * nst[d]; }
                if (!isctx) {
                    pn += __shfl_xor(pn, 1); pn += __shfl_xor(pn, 2); pn += __shfl_xor(pn, 4); pn += __shfl_xor(pn, 8);
                    pd += __shfl_xor(pd, 1); pd += __shfl_xor(pd, 2); pd += __shfl_xor(pd, 4); pd += __shfl_xor(pd, 8);
                    if (g == 0) { const int tok = rowbase + (dir ? 63 - p : p);
                        Hout[(size_t)tok * D + h * 256 + dvb * 32 + j] = (bf16)f2bf(pn / fmaxf(fabsf(pd), 1.0f)); }
                }
            }
        }
    }
}


namespace pg8 {
typedef short bf16x8 __attribute__((ext_vector_type(8)));
constexpr int BM = 256, BK = 64, HALF = 128, HTB = HALF * BK * 2, STAGE_BYTES = 8 * HTB, NXCD = 8, WGM = 8;
__host__ __device__ __forceinline__ int lds_byte(int r, int c) { const int st = (r >> 4) * 2 + (c >> 5), rr = r & 15, cc = c & 31, ob = rr * 64 + cc * 2; return st * 1024 + (ob ^ (((ob >> 9) & 1) << 5)); }
__host__ __device__ __forceinline__ void stage_rc(int b, int& R, int& C) { const int st = b / 1024, sb = b % 1024, swz = sb ^ (((sb >> 9) & 1) << 5); R = (st >> 1) * 16 + swz / 64; C = (st & 1) * 32 + (swz % 64) / 2; }
__host__ __device__ __forceinline__ int perm32(int rho) { const int n = rho >> 4, i = rho & 15; return 8 * (i >> 2) + 4 * n + (i & 3); }
struct Unit { int pm, pn; };
struct Gemm { const bf16* A; const bf16* Bt; int lda, ldb, K, mode;
    __device__ __forceinline__ size_t a_off(const Unit& u) const { return mode == 0 ? (size_t)u.pm * 256 * lda : (size_t)(u.pm & 15) * 256 * lda; }
    __device__ __forceinline__ size_t b_off(const Unit& u) const { return mode == 0 ? (size_t)u.pn * 256 * ldb : (size_t)((u.pm >> 4) * 1024 + u.pn * 256) * ldb; }
};
struct StaticOrder {
    int nM, nN, nwg, G, c;
    __device__ __forceinline__ void init(int nM_, int nN_, int G_, int c_) { nM = nM_; nN = nN_; nwg = nM * nN; G = G_; c = c_; }
    __device__ __forceinline__ bool next(int i, Unit& u) const {
        const long L = (long)i * G + c; if (L >= nwg) return false;
        int wgid = (int)L; { const int q = nwg / NXCD, r = nwg % NXCD, xcd = wgid % NXCD, off = wgid / NXCD; wgid = (xcd < r ? xcd * (q + 1) : r * (q + 1) + (xcd - r) * q) + off; }
        const int nig = WGM * nN, gid = wgid / nig, fm = gid * WGM, gsz = (nM - fm) < WGM ? (nM - fm) : WGM;
        u.pm = fm + ((wgid % nig) % gsz); u.pn = (wgid % nig) / gsz; return true;
    }
};
__device__ __forceinline__ unsigned cvt_pk_bf16(float lo, float hi) { unsigned r; asm volatile("v_cvt_pk_bf16_f32 %0, %1, %2" : "=v"(r) : "v"(lo), "v"(hi)); return r; }
__device__ __forceinline__ u32x4 pack8(const f32x4 v0, const f32x4 v1) { u32x4 w; w.x = cvt_pk_bf16(v0[0], v0[1]); w.y = cvt_pk_bf16(v0[2], v0[3]); w.z = cvt_pk_bf16(v1[0], v1[1]); w.w = cvt_pk_bf16(v1[2], v1[3]); return w; }

struct EpiF32 {
    static constexpr bool PERM = false;
    float* C; int ldc; const float* bias;
    __device__ __forceinline__ void operator()(const f32x4 (&acc)[2][2][4][2], const Unit& u, int wr, int wc, int fr, int fq) const {
        const int row0 = u.pm * BM + wr * 64 + fr, col0 = u.pn * BM + wc * 32 + 4 * fq;
        f32x4 bv[2][2];
#pragma unroll
        for (int bj = 0; bj < 2; ++bj)
#pragma unroll
            for (int n = 0; n < 2; ++n) bv[bj][n] = bias ? *(const f32x4*)(bias + col0 + bj * HALF + n * 16) : (f32x4){0.f, 0.f, 0.f, 0.f};
#pragma unroll
        for (int ai = 0; ai < 2; ++ai)
#pragma unroll
            for (int m = 0; m < 4; ++m) { float* rowp = C + (size_t)(row0 + ai * HALF + m * 16) * ldc + col0;
#pragma unroll
                for (int bj = 0; bj < 2; ++bj)
#pragma unroll
                    for (int n = 0; n < 2; ++n) *(f32x4*)(rowp + bj * HALF + n * 16) = acc[ai][bj][m][n] + bv[bj][n]; }
    }
};
struct EpiInProj {
    static constexpr bool PERM = true;
    bf16 *Q, *Kb, *V, *O; float* Gt; const float* bias;
    __device__ __forceinline__ void operator()(const f32x4 (&acc)[2][2][4][2], const Unit& u, int wr, int wc, int fr, int fq) const {
        const int pn = u.pn, pm = u.pm, row0 = pm * BM + wr * 64 + fr;
        if (pn == 12) {
            if (wc == 0 && fq < 2) {
                const f32x4 b0 = *(const f32x4*)(bias + 3072 + 8 * fq), b1 = *(const f32x4*)(bias + 3072 + 8 * fq + 4);
#pragma unroll
                for (int ai = 0; ai < 2; ++ai)
#pragma unroll
                    for (int m = 0; m < 4; ++m) { float* p = Gt + (size_t)(row0 + ai * HALF + m * 16) * 16 + 8 * fq;
                        *(f32x4*)p = acc[ai][0][m][0] + b0; *(f32x4*)(p + 4) = acc[ai][0][m][1] + b1; }
            }
            return;
        }
        if (pm >= 64 && (pn < 2 || pn >= 8)) return;
        bf16* base; int ldc, colt; float sc = 1.f;
        if (pn < 2) { base = Q; ldc = 512; colt = pn * 256; }
        else if (pn < 4) { base = Kb; ldc = 512; colt = (pn - 2) * 256; sc = 0.08838834764831845f; }
        else if (pn < 8) { base = V; ldc = 1024; colt = (pn - 4) * 256; }
        else { base = O; ldc = 1024; colt = (pn - 8) * 256; }
        const int col0 = colt + wc * 32 + 8 * fq, bcol0 = pn * BM + wc * 32 + 8 * fq;
        f32x4 bv[2][2];
#pragma unroll
        for (int bj = 0; bj < 2; ++bj)
#pragma unroll
            for (int n = 0; n < 2; ++n) bv[bj][n] = *(const f32x4*)(bias + bcol0 + bj * HALF + 4 * n);
#pragma unroll
        for (int ai = 0; ai < 2; ++ai)
#pragma unroll
            for (int m = 0; m < 4; ++m) { bf16* rowp = base + (size_t)(row0 + ai * HALF + m * 16) * ldc + col0;
#pragma unroll
                for (int bj = 0; bj < 2; ++bj) { const f32x4 v0 = (acc[ai][bj][m][0] + bv[bj][0]) * sc, v1 = (acc[ai][bj][m][1] + bv[bj][1]) * sc;
                    *(u32x4*)(rowp + bj * HALF) = pack8(v0, v1); } }
    }
};
struct EpiSeqMix {
    static constexpr bool PERM = true;
    bf16* PQ;
    __device__ __forceinline__ void operator()(const f32x4 (&acc)[2][2][4][2], const Unit& u, int wr, int wc, int fr, int fq) const {
        const int b = u.pm >> 4, rt = u.pm & 15;
        const int row0 = b * 2048 + (rt & 7) * 256 + wr * 64 + fr, col0 = (rt >> 3) * 1024 + u.pn * 256 + wc * 32 + 8 * fq;
#pragma unroll
        for (int ai = 0; ai < 2; ++ai)
#pragma unroll
            for (int m = 0; m < 4; ++m) { bf16* rowp = PQ + (size_t)(row0 + ai * HALF + m * 16) * 2048 + col0;
#pragma unroll
                for (int bj = 0; bj < 2; ++bj) *(u32x4*)(rowp + bj * HALF) = pack8(acc[ai][bj][m][0], acc[ai][bj][m][1]); }
    }
};
__device__ __forceinline__ float dpp_ror1(float v) { return __int_as_float(__builtin_amdgcn_update_dpp(0, __float_as_int(v), 0x121, 0xf, 0xf, false)); }
__device__ __forceinline__ float dpp_rol1(float v) { return __int_as_float(__builtin_amdgcn_update_dpp(0, __float_as_int(v), 0x12f, 0xf, 0xf, false)); }
struct EpiUpConv {
    static constexpr bool PERM = true;
    bf16* ACT; const float* cw; const float* cb;
    __device__ __forceinline__ void operator()(const f32x4 (&acc)[2][2][4][2], const Unit& u, int wr, int wc, int fr, int fq) const {
        const int f0 = u.pn * 128 + wc * 32 + 8 * fq, row0 = u.pm * BM + wr * 64 + fr;
        f32x4 w0[2], w1[2], w2[2], bb[2];
#pragma unroll
        for (int n = 0; n < 2; ++n) { w0[n] = *(const f32x4*)(cw + f0 + 4 * n); w1[n] = *(const f32x4*)(cw + FF + f0 + 4 * n); w2[n] = *(const f32x4*)(cw + 2 * FF + f0 + 4 * n); bb[n] = *(const f32x4*)(cb + f0 + 4 * n); }
        const bool first = (fr == 0), last = (fr == 15);
#pragma unroll
        for (int ai = 0; ai < 2; ++ai) {
            f32x4 res[4][2];
#pragma unroll
            for (int n = 0; n < 2; ++n) {
                f32x4 R[4], L[4];
#pragma unroll
                for (int m = 0; m < 4; ++m)
#pragma unroll
                    for (int e = 0; e < 4; ++e) { R[m][e] = dpp_ror1(acc[ai][1][m][n][e]); L[m][e] = dpp_rol1(acc[ai][1][m][n][e]); }
#pragma unroll
                for (int m = 0; m < 4; ++m)
#pragma unroll
                    for (int e = 0; e < 4; ++e) {
                        const float pv = first ? (m > 0 ? R[m > 0 ? m - 1 : 0][e] : 0.f) : R[m][e];
                        const float nv = last ? (m < 3 ? L[m < 3 ? m + 1 : 3][e] : 0.f) : L[m][e];
                        const float gc = pv * w0[n][e] + acc[ai][1][m][n][e] * w1[n][e] + nv * w2[n][e] + bb[n][e];
                        res[m][n][e] = gc * __builtin_amdgcn_rcpf(1.f + __expf(-gc)) * acc[ai][0][m][n][e];
                    }
            }
#pragma unroll
            for (int m = 0; m < 4; ++m) *(u32x4*)(ACT + (size_t)(row0 + ai * HALF + m * 16) * FF + f0) = pack8(res[m][0], res[m][1]);
        }
    }
};

template <class Epi, bool ALIGN_EPI = true>
__device__ __forceinline__ void gemm_phase(LAS unsigned char* lds, const Gemm g, const StaticOrder& S, const Epi& E) {
    const int tid = threadIdx.x, wid = __builtin_amdgcn_readfirstlane(tid >> 6), lane = tid & 63, wr = wid >> 2, wc = wid & 3, fr = lane & 15, fq = lane >> 4;
    const int K = g.K, nt = K / BK;
    unsigned voffA[2], voffB[2];
#pragma unroll
    for (int i = 0; i < 2; ++i) { int R, C; stage_rc(tid * 16 + i * 8192, R, C); const int Rb = Epi::PERM ? ((R & ~31) + perm32(R & 31)) : R;
        voffA[i] = (unsigned)(R * g.lda + C) * 2u; voffB[i] = (unsigned)(Rb * g.ldb + C) * 2u; }
    const size_t kstep = (size_t)(BK * 2);
    const size_t hstepA = (size_t)HALF * g.lda * 2, hstepB = (size_t)HALF * g.ldb * 2;
    const unsigned ldsw = (unsigned)wid * 1024u;
    const int aoff = lds_byte(wr * 64 + fr, fq * 8), boff = lds_byte(wc * 32 + fr, fq * 8);
#define PG8_SA(b, h) (((b) * 2 + (h)) * HTB)
#define PG8_SB(b, h) ((4 + (b) * 2 + (h)) * HTB)
#define PG8_STAGE(bufoff, gbase, voff) do { _Pragma("unroll") for (int _i = 0; _i < 2; ++_i) \
        __builtin_amdgcn_global_load_lds((const unsigned*)((const char*)(gbase) + (voff)[_i]), (LAS unsigned*)(lds + (bufoff) + ldsw + _i * 8192), 16, 0, 0); } while (0)
#define PG8_LDA(dst, b, h) do { _Pragma("unroll") for (int m = 0; m < 4; ++m) _Pragma("unroll") for (int k = 0; k < 2; ++k) dst[m][k] = *(const LAS bf16x8*)(lds + PG8_SA(b, h) + aoff + m * 2048 + k * 1024); } while (0)
#define PG8_LDB(dst, b, h) do { _Pragma("unroll") for (int n = 0; n < 2; ++n) _Pragma("unroll") for (int k = 0; k < 2; ++k) dst[n][k] = *(const LAS bf16x8*)(lds + PG8_SB(b, h) + boff + n * 2048 + k * 1024); } while (0)
#define PG8_MMA(ai, bj, At, Bt) do { __builtin_amdgcn_s_setprio(1); _Pragma("unroll") for (int m = 0; m < 4; ++m) _Pragma("unroll") for (int n = 0; n < 2; ++n) _Pragma("unroll") for (int k = 0; k < 2; ++k) \
        acc[ai][bj][m][n] = __builtin_amdgcn_mfma_f32_16x16x32_bf16(Bt[n][k], At[m][k], acc[ai][bj][m][n], 0, 0, 0); __builtin_amdgcn_s_setprio(0); } while (0)
#define PG8_WAIT_V(n) asm volatile("s_waitcnt vmcnt(" #n ")" ::: "memory")
#define PG8_WAIT_L(n) asm volatile("s_waitcnt lgkmcnt(" #n ")" ::: "memory")
#define PG8_BAR __builtin_amdgcn_s_barrier()
#define PG8_SCHED __builtin_amdgcn_sched_barrier(0)
    Unit cur, nxt; int ui = 0;
    if (!S.next(0, cur)) return;
    f32x4 acc[2][2][4][2];
#pragma unroll
    for (int a = 0; a < 2; ++a)
#pragma unroll
        for (int b = 0; b < 2; ++b)
#pragma unroll
            for (int m = 0; m < 4; ++m)
#pragma unroll
                for (int n = 0; n < 2; ++n) acc[a][b][m][n] = (f32x4){0.f, 0.f, 0.f, 0.f};
    bf16x8 At[4][2], B0[2][2], B1[2][2];
    const char* cA = (const char*)g.A + g.a_off(cur) * 2; const char* cB = (const char*)g.Bt + g.b_off(cur) * 2;
    PG8_STAGE(PG8_SB(0, 0), cB, voffB); PG8_STAGE(PG8_SB(0, 1), cB + hstepB, voffB); PG8_STAGE(PG8_SA(0, 0), cA, voffA); PG8_STAGE(PG8_SA(0, 1), cA + hstepA, voffA);
    if (wr == 1) PG8_BAR;
    PG8_WAIT_V(2); PG8_BAR;
    PG8_STAGE(PG8_SB(1, 0), cB + kstep, voffB); PG8_STAGE(PG8_SA(1, 0), cA + kstep, voffA); PG8_STAGE(PG8_SB(1, 1), cB + hstepB + kstep, voffB);
    PG8_WAIT_V(6); PG8_BAR;
    for (;;) {
        const bool has_next = S.next(ui + 1, nxt);
        const char* nA = has_next ? (const char*)g.A + g.a_off(nxt) * 2 : cA; const char* nB = has_next ? (const char*)g.Bt + g.b_off(nxt) * 2 : cB;
        for (int t = 0; t < nt; t += 2) {
            const bool last = (t == nt - 2);
            const char* a1 = cA + (size_t)(t + 1) * kstep;
            const char* a2 = last ? nA : cA + (size_t)(t + 2) * kstep; const char* b2 = last ? nB : cB + (size_t)(t + 2) * kstep;
            const char* a3 = a2 + kstep; const char* b3 = b2 + kstep;
            PG8_LDB(B0, 0, 0); PG8_LDB(B1, 0, 1); PG8_SCHED; PG8_LDA(At, 0, 0); PG8_STAGE(PG8_SA(1, 1), a1 + hstepA, voffA);
            PG8_WAIT_V(8); PG8_WAIT_L(0); PG8_BAR; PG8_MMA(0, 0, At, B0); PG8_MMA(0, 1, At, B1); PG8_BAR; PG8_SCHED;
            PG8_LDA(At, 0, 1); PG8_STAGE(PG8_SB(0, 0), b2, voffB); PG8_STAGE(PG8_SB(0, 1), b2 + hstepB, voffB); PG8_STAGE(PG8_SA(0, 0), a2, voffA);
            PG8_WAIT_V(8); PG8_WAIT_L(0); PG8_BAR; PG8_MMA(1, 0, At, B0); PG8_MMA(1, 1, At, B1); PG8_BAR; PG8_SCHED;
            PG8_LDB(B0, 1, 0); PG8_LDB(B1, 1, 1); PG8_SCHED; PG8_LDA(At, 1, 0); PG8_STAGE(PG8_SA(0, 1), a2 + hstepA, voffA);
            PG8_WAIT_V(8); PG8_WAIT_L(0); PG8_BAR; PG8_MMA(0, 0, At, B0); PG8_MMA(0, 1, At, B1); PG8_BAR; PG8_SCHED;
            PG8_LDA(At, 1, 1); PG8_STAGE(PG8_SB(1, 0), b3, voffB); PG8_STAGE(PG8_SB(1, 1), b3 + hstepB, voffB); PG8_STAGE(PG8_SA(1, 0), a3, voffA);
            PG8_WAIT_V(8); PG8_WAIT_L(0); PG8_BAR; PG8_MMA(1, 0, At, B0); PG8_MMA(1, 1, At, B1); PG8_BAR; PG8_SCHED;
        }
        if constexpr (ALIGN_EPI) { if (wr == 0) PG8_BAR; }
        E(acc, cur, wr, wc, fr, fq);
        if (!has_next) break;
#pragma unroll
        for (int a = 0; a < 2; ++a)
#pragma unroll
            for (int b = 0; b < 2; ++b)
#pragma unroll
                for (int m = 0; m < 4; ++m)
#pragma unroll
                    for (int n = 0; n < 2; ++n) acc[a][b][m][n] = (f32x4){0.f, 0.f, 0.f, 0.f};
        cur = nxt; cA = nA; cB = nB; ++ui;
        if constexpr (ALIGN_EPI) { if (wr == 1) PG8_BAR; }
    }
    PG8_WAIT_V(0);
    if constexpr (!ALIGN_EPI) { if (wr == 0) PG8_BAR; }
    PG8_BAR;
#undef PG8_SA
#undef PG8_SB
#undef PG8_STAGE
#undef PG8_LDA
#undef PG8_LDB
#undef PG8_MMA
#undef PG8_WAIT_V
#undef PG8_WAIT_L
#undef PG8_BAR
#undef PG8_SCHED
}
}

#ifndef FAST_GEMM
#define FAST_GEMM 1
#endif


#define XB_TMO      128
#define XB_XCNT(j)  (256  + 64 * (j))
#define XB_XSUB(j)  (1280 + 64 * (j))
#define XB_XGEN(j)  (2304 + 64 * (j))
#define XB_TOP      3328
#define XB_TOPGEN   3392
#define XCD_BAR_WORDS 3456
#define XB_SPIN_CAP (1u << 20)
__device__ __forceinline__ unsigned xb_ld(unsigned* p)              { return __hip_atomic_load(p, __ATOMIC_RELAXED, __HIP_MEMORY_SCOPE_AGENT); }
__device__ __forceinline__ unsigned xb_add(unsigned* p, unsigned v) { return __hip_atomic_fetch_add(p, v, __ATOMIC_RELAXED, __HIP_MEMORY_SCOPE_AGENT); }
__device__ __forceinline__ unsigned xb_xcc_id() { return (unsigned)__builtin_amdgcn_s_getreg((3 << 11) | 20) & 0xFu; }
#define XB_SPIN(cond, bar) do { unsigned _sp = 0; while (cond) { __builtin_amdgcn_s_sleep(1); \
    if ((++_sp & 255u) == 0u) { if (xb_ld(&(bar)[XB_TMO])) break; if (_sp > XB_SPIN_CAP) { atomicAdd(&(bar)[XB_TMO], 1u); break; } } } } while (0)
struct XcdBarrier { unsigned* bar; unsigned x; volatile LAS unsigned* st; };
__device__ __forceinline__ XcdBarrier xcd_barrier_post(unsigned* bar, volatile LAS unsigned* st) {
    XcdBarrier b; b.bar = bar; b.x = xb_xcc_id(); b.st = st;
    if (threadIdx.x == 0) (void)xb_add(&bar[XB_XCNT(b.x)], 1u);
    return b;
}
__device__ __forceinline__ void xcd_barrier_complete(unsigned* bar, unsigned x, unsigned& nloc, unsigned& nx) {
    const unsigned G = gridDim.x * gridDim.y * gridDim.z;
    unsigned sum, cnt, mine, sp = 0u;
    for (;;) {
        sum = 0u; cnt = 0u; mine = 0u;
#pragma unroll
        for (unsigned j = 0; j < 16; ++j) { const unsigned c = xb_ld(&bar[XB_XCNT(j)]); sum += c; cnt += (c > 0u) ? 1u : 0u; mine = (j == x) ? c : mine; }
        if (sum == G) break;
        __builtin_amdgcn_s_sleep(1);
        if ((++sp & 255u) == 0u) { if (xb_ld(&bar[XB_TMO])) break; if (sp > XB_SPIN_CAP) { atomicAdd(&bar[XB_TMO], 1u); break; } }
    }
    nloc = mine > 0u ? mine : 1u; nx = cnt > 0u ? cnt : 1u;
}
__device__ __forceinline__ void xcd_barrier(const XcdBarrier& b) {
    asm volatile("s_waitcnt vmcnt(0)" ::: "memory");
    __syncthreads();
    if (threadIdx.x == 0) {
        unsigned* bar = b.bar;
        __builtin_amdgcn_s_waitcnt(0);
        unsigned nloc = b.st[0], nx = b.st[1];
        if (nloc == 0u) { xcd_barrier_complete(bar, b.x, nloc, nx); b.st[0] = nloc; b.st[1] = nx; }
        const unsigned old = xb_add(&bar[XB_XSUB(b.x)], 1u);
        const unsigned gen = old / nloc;
        if (old + 1u == (gen + 1u) * nloc) {
            __builtin_amdgcn_fence(__ATOMIC_RELEASE, "agent");
            asm volatile("s_waitcnt vmcnt(0)" ::: "memory");
            const unsigned og = xb_add(&bar[XB_TOP], 1u);
            const unsigned tg = og / nx;
            if (og + 1u == (tg + 1u) * nx) xb_add(&bar[XB_TOPGEN], 1u);
            else XB_SPIN(xb_ld(&bar[XB_TOPGEN]) == tg, bar);
            __builtin_amdgcn_fence(__ATOMIC_ACQUIRE, "agent");
            xb_add(&bar[XB_XGEN(b.x)], 1u);
            asm volatile("s_waitcnt vmcnt(0)" ::: "memory");
        } else {
            XB_SPIN(xb_ld(&bar[XB_XGEN(b.x)]) == gen, bar);
            __builtin_amdgcn_fence(__ATOMIC_ACQUIRE, "agent");
            asm volatile("s_waitcnt vmcnt(0)" ::: "memory");
        }
    }
    __syncthreads();
}

__global__ void __launch_bounds__(NTHR, 2) mk_fwd(Args a) {
    extern __shared__ __attribute__((aligned(16))) unsigned char lds_raw[];
    LAS unsigned char* lds = (LAS unsigned char*)lds_raw;
    const int tid = threadIdx.x, lane = tid & 63, wave = __builtin_amdgcn_readfirstlane(tid >> 6), G = gridDim.x;
    const int lo = a.ph_lo, hi = a.ph_hi;
    unsigned char* ws = a.ws;
    const float* MOD0 = (const float*)(ws + WS_MOD); const float* MOD1 = MOD0 + 9 * 6144;
#define IN(k) (lo <= (k) && (k) < hi)
#define SEAM(k) do { if (IN(k) && IN((k) + 1)) { if ((k) == 0) { __threadfence(); cg::this_grid().sync(); } else xcd_barrier(xbar); } } while (0)
    {
        volatile LAS unsigned* st = (volatile LAS unsigned*)(lds + LDS_BYTES - 64);
        if (tid < 16) st[tid] = 0u;
        __syncthreads();
    }
    XcdBarrier xbar = xcd_barrier_post((unsigned*)(ws + WS_CTL) + 4096, (volatile LAS unsigned*)(lds + LDS_BYTES - 64));

    if (IN(0)) { p0_prep(a, lds, tid, lane, wave, G); } SEAM(0);
    if (IN(1)) { p1_norm_mod(a, lane, wave, G); } SEAM(1);
#if FAST_GEMM
    if (IN(2)) { pg8::Gemm g{(const bf16*)(ws + WS_A), (const bf16*)(ws + WS_WIN), D, D, D, 0}; pg8::StaticOrder S; S.init(MALL / 256, NPROJ_PAD / 256, G, (int)blockIdx.x);
        pg8::EpiInProj E{(bf16*)(ws + WS_Q), (bf16*)(ws + WS_K), (bf16*)(ws + WS_V), (bf16*)(ws + WS_O), (float*)(ws + WS_G), a.in[15]};
        pg8::gemm_phase<pg8::EpiInProj>(lds, g, S, E); } SEAM(2);
#else
    if (IN(2)) { p2_inproj_simple(a, lds, tid, G); } SEAM(2);
#endif
    if (IN(3)) { p3_mlstm_simple(a, lds, tid, G); } SEAM(3);
    if (IN(4)) { p4_readout(a, lane, wave, G); } SEAM(4);
#if FAST_GEMM
    if (IN(5)) { pg8::Gemm g{(const bf16*)(ws + WS_Y), (const bf16*)(ws + WS_WOUT), D, D, D, 0}; pg8::StaticOrder S; S.init(ML / 256, D / 256, G, (int)blockIdx.x);
        pg8::EpiF32 E{(float*)(ws + WS_Y1), D, nullptr}; pg8::gemm_phase<pg8::EpiF32>(lds, g, S, E); } SEAM(5);
#else
    if (IN(5)) { gemm_simple_f32((const bf16*)(ws + WS_Y), D, (const bf16*)(ws + WS_WOUT), D, ML, D, D, (float*)(ws + WS_Y1), D, nullptr, lds, tid, G); } SEAM(5);
#endif
    if (IN(6)) { rowpass<1>((const float*)(ws + WS_Y1), a.in[0], a.out, MOD0 + 2 * D, a.in[7], a.in[8], MOD0 + 3 * D, MOD0 + 4 * D, (bf16*)(ws + WS_H2), lane, wave, G); } SEAM(6);
#if FAST_GEMM
    if (IN(7)) { pg8::Gemm g{(const bf16*)(ws + WS_H2), (const bf16*)(ws + WS_WUP), D, D, D, 0}; pg8::StaticOrder S; S.init(ML / 256, NUP / 256, G, (int)blockIdx.x);
        pg8::EpiUpConv E{(bf16*)(ws + WS_ACT), a.in[11], a.in[12]}; pg8::gemm_phase<pg8::EpiUpConv>(lds, g, S, E); } SEAM(7);
    if (IN(8)) { pg8::Gemm g{(const bf16*)(ws + WS_ACT), (const bf16*)(ws + WS_WDN), FF, FF, FF, 0}; pg8::StaticOrder S; S.init(ML / 256, D / 256, G, (int)blockIdx.x);
        pg8::EpiF32 E{(float*)(ws + WS_Y2), D, nullptr}; pg8::gemm_phase<pg8::EpiF32>(lds, g, S, E); } SEAM(8);
#else
    if (IN(7)) { p7_up_simple((const bf16*)(ws + WS_H2), (const bf16*)(ws + WS_WUP), a.in[11], a.in[12], (bf16*)(ws + WS_ACT), lds, tid, G); } SEAM(7);
    if (IN(8)) { gemm_simple_f32((const bf16*)(ws + WS_ACT), FF, (const bf16*)(ws + WS_WDN), FF, ML, D, FF, (float*)(ws + WS_Y2), D, nullptr, lds, tid, G); } SEAM(8);
#endif
    if (IN(9)) { rowpass_t((const float*)(ws + WS_Y2), a.out, a.out, MOD0 + 5 * D, a.in[9], a.in[6] + D, MOD1, MOD1 + D, (bf16*)(ws + WS_HT), lds, tid, lane, wave, G); } SEAM(9);
#if FAST_GEMM
    if (IN(10)) { pg8::Gemm g{(const bf16*)(ws + WS_DFT), (const bf16*)(ws + WS_HT), 2048, 2048, 2048, 1}; pg8::StaticOrder S; S.init(NB * 16, 4, G, (int)blockIdx.x);
        pg8::EpiSeqMix E{(bf16*)(ws + WS_PQ)}; pg8::gemm_phase<pg8::EpiSeqMix>(lds, g, S, E); } SEAM(10);
    if (IN(11)) { pg8::Gemm g{(const bf16*)(ws + WS_PQ), (const bf16*)(ws + WS_WCS), 2048, 2048, 2048, 0}; pg8::StaticOrder S; S.init(ML / 256, D / 256, G, (int)blockIdx.x);
        pg8::EpiF32 E{(float*)(ws + WS_Y3), D, a.in[19]}; pg8::gemm_phase<pg8::EpiF32>(lds, g, S, E); } SEAM(11);
#else
    if (IN(10)) { p10_seqmix_simple(a, lds, tid, G); } SEAM(10);
    if (IN(11)) { gemm_simple_f32((const bf16*)(ws + WS_PQ), 2048, (const bf16*)(ws + WS_WCS), 2048, ML, D, 2048, (float*)(ws + WS_Y3), D, a.in[19], lds, tid, G); } SEAM(11);
#endif
    if (IN(12)) { rowpass<1>((const float*)(ws + WS_Y3), a.out, a.out, MOD1 + 2 * D, a.in[7] + D, a.in[8] + D, MOD1 + 3 * D, MOD1 + 4 * D, (bf16*)(ws + WS_H2B), lane, wave, G); } SEAM(12);
#if FAST_GEMM
    if (IN(13)) { pg8::Gemm g{(const bf16*)(ws + WS_H2B), (const bf16*)(ws + WS_WUP) + (size_t)NUP * D, D, D, D, 0}; pg8::StaticOrder S; S.init(ML / 256, NUP / 256, G, (int)blockIdx.x);
        pg8::EpiUpConv E{(bf16*)(ws + WS_ACT1), a.in[11] + 3 * FF, a.in[12] + FF}; pg8::gemm_phase<pg8::EpiUpConv>(lds, g, S, E); } SEAM(13);
    if (IN(14)) { pg8::Gemm g{(const bf16*)(ws + WS_ACT1), (const bf16*)(ws + WS_WDN) + (size_t)D * FF, FF, FF, FF, 0}; pg8::StaticOrder S; S.init(ML / 256, D / 256, G, (int)blockIdx.x);
        pg8::EpiF32 E{(float*)(ws + WS_Y2B), D, nullptr}; pg8::gemm_phase<pg8::EpiF32>(lds, g, S, E); } SEAM(14);
#else
    if (IN(13)) { p7_up_simple((const bf16*)(ws + WS_H2B), (const bf16*)(ws + WS_WUP) + (size_t)NUP * D, a.in[11] + 3 * FF, a.in[12] + FF, (bf16*)(ws + WS_ACT1), lds, tid, G); } SEAM(13);
    if (IN(14)) { gemm_simple_f32((const bf16*)(ws + WS_ACT1), FF, (const bf16*)(ws + WS_WDN) + (size_t)D * FF, FF, ML, D, FF, (float*)(ws + WS_Y2B), D, nullptr, lds, tid, G); } SEAM(14);
#endif
    if (IN(15)) { rowpass<0>((const float*)(ws + WS_Y2B), a.out, a.out, MOD1 + 5 * D, a.in[9] + D, nullptr, nullptr, nullptr, nullptr, lane, wave, G); }
#undef IN
#undef SEAM
}

extern "C" void kernel_launch(void* const* d_in, const int* in_sizes, int n_in, void* d_out, int out_size, void* d_ws, size_t ws_size, hipStream_t stream) {
    static int grid = 0;
    if (grid == 0) {
        if (n_in != 20 || out_size != ML * D || ws_size < WS_END) { fprintf(stderr, "kernel_launch: unexpected shapes (n_in %d out %d ws %zu)\n", n_in, out_size, ws_size); grid = -1; return; }
        int dev = 0, cus = 0, per_cu = 0;
        (void)hipGetDevice(&dev); (void)hipDeviceGetAttribute(&cus, hipDeviceAttributeMultiprocessorCount, dev);
        (void)hipFuncSetAttribute((const void*)mk_fwd, hipFuncAttributeMaxDynamicSharedMemorySize, LDS_BYTES);
        (void)hipOccupancyMaxActiveBlocksPerMultiprocessor(&per_cu, (const void*)mk_fwd, NTHR, LDS_BYTES);
        if (per_cu < 1) { fprintf(stderr, "kernel_launch: occupancy query says %d blocks/CU\n", per_cu); per_cu = 1; }
        grid = cus * 1;
        (void)hipGetLastError();
    }
    if (grid < 0) return;
    (void)hipMemsetAsync((char*)d_ws + WS_CTL, 0, 1 * MiB, stream);
    Args a{};
    for (int i = 0; i < 20; ++i) a.in[i] = (const float*)d_in[i];
    a.out = (float*)d_out; a.ws = (unsigned char*)d_ws;
    if (MK_N_LAUNCHES == 1) {
        a.ph_lo = 0; a.ph_hi = NPH;
        void* args[] = {&a};
        hipError_t e = hipLaunchCooperativeKernel((const void*)mk_fwd, dim3(grid), dim3(NTHR), args, LDS_BYTES, stream);
        if (e != hipSuccess) fprintf(stderr, "cooperative launch failed: %s (grid %d)\n", hipGetErrorString(e), grid);
    } else {
        for (int p = 0; p < NPH; ++p) { a.ph_lo = p; a.ph_hi = p + 1;
            hipLaunchKernelGGL(mk_fwd, dim3(grid), dim3(NTHR), LDS_BYTES, stream, a); }
    }
}
```

```cpp
#include <hip/hip_runtime.h>
#include <hip/hip_cooperative_groups.h>
#include <cstdio>
#include <cstdint>
namespace cg = cooperative_groups;

#ifndef MK_N_LAUNCHES
#define MK_N_LAUNCHES 1
#endif

#define GAS __attribute__((address_space(1)))
#define LAS __attribute__((address_space(3)))
typedef unsigned short bf16;
typedef float f32x4 __attribute__((ext_vector_type(4)));
typedef unsigned u32x4 __attribute__((ext_vector_type(4)));
typedef unsigned u32x2 __attribute__((ext_vector_type(2)));

constexpr int D = 1024, NB = 8, T = 2048, TC = 256;
constexpr int ML = NB * T;
constexpr int MC = NB * TC;
constexpr int MALL = ML + MC;
constexpr int NH = 4, DK = 128, DV = 256;
constexpr int NPROJ = 3088, NPROJ_PAD = 3328;
constexpr int FF = 2816, NUP = 2 * FF;
constexpr float EPS = 1e-6f;
constexpr int NPH = 16;
constexpr int NWAVES = 8, NTHR = 512;

constexpr size_t MiB = 1u << 20;
constexpr size_t WS_CTL = 0;
constexpr size_t WS_MOD = 1 * MiB;
constexpr size_t WS_WIN = 2 * MiB;
constexpr size_t WS_WOUT = WS_WIN + (size_t)NPROJ_PAD * D * 2;
constexpr size_t WS_WUP = WS_WOUT + (size_t)D * D * 2;
constexpr size_t WS_WDN = WS_WUP + (size_t)2 * NUP * D * 2;
constexpr size_t WS_WCS = WS_WDN + (size_t)2 * D * FF * 2;
constexpr size_t WS_DFT = WS_WCS + (size_t)D * 2048 * 2;
constexpr size_t WS_A = WS_DFT + (size_t)4096 * 2048 * 2;
constexpr size_t WS_C = WS_A + (size_t)MALL * D * 2;
constexpr size_t WS_B = WS_C + (size_t)ML * D * 2;
constexpr size_t WS_Q = WS_B;
constexpr size_t WS_K = WS_Q + (size_t)ML * 512 * 2;
constexpr size_t WS_V = WS_K + (size_t)MALL * 512 * 2;
constexpr size_t WS_O = WS_V + (size_t)MALL * D * 2;
constexpr size_t WS_G = WS_O + (size_t)ML * D * 2;
constexpr size_t WS_END = WS_B + 104 * MiB;
static_assert(WS_G + (size_t)MALL * 16 * 4 <= WS_END, "region B");
static_assert(WS_END <= 256 * MiB, "workspace");
constexpr size_t WS_HF = WS_A;
constexpr size_t WS_HB = WS_C;
constexpr size_t WS_Y = WS_Q;
constexpr size_t WS_Y1 = WS_V;
constexpr size_t WS_H2 = WS_A;
constexpr size_t WS_ACT = WS_B;
constexpr size_t WS_Y2 = WS_A;
constexpr size_t WS_HT = WS_B;
constexpr size_t WS_PQ = WS_B + 32 * MiB;
constexpr size_t WS_Y3 = WS_A;
constexpr size_t WS_H2B = WS_B + 72 * MiB;
constexpr size_t WS_ACT1 = WS_A;
constexpr size_t WS_Y2B = WS_B + 24 * MiB;
static_assert(WS_V + (size_t)ML * D * 4 <= WS_G, "y1 overlay");
static_assert(WS_ACT1 + (size_t)ML * FF * 2 <= WS_H2B && WS_ACT1 + (size_t)ML * FF * 2 <= WS_Y2B, "layer-1 overlays");
static_assert(WS_Y2B + (size_t)ML * D * 4 <= WS_END && WS_H2B + (size_t)ML * D * 2 <= WS_END && WS_PQ + (size_t)ML * 2048 * 2 <= WS_END, "layer-1 overlays");

constexpr int LDS_BYTES = 147456;

__device__ __forceinline__ float bf2f(unsigned v) { return __uint_as_float(v << 16); }
__device__ __forceinline__ unsigned f2bf(float f) { unsigned u = __float_as_uint(f); return (u + 0x7fffu + ((u >> 16) & 1u)) >> 16; }
__device__ __forceinline__ unsigned pk2(float lo, float hi) { return f2bf(lo) | (f2bf(hi) << 16); }
__device__ __forceinline__ float silu_f(float v) { return v / (1.f + __expf(-v)); }
__device__ __forceinline__ float sigmoid_f(float v) { return 1.f / (1.f + __expf(-v)); }
__device__ __forceinline__ float logsigmoid_f(float v) { return fminf(v, 0.f) - log1pf(__expf(-fabsf(v))); }
__device__ __forceinline__ float wave_sum(float v) {
#pragma unroll
    for (int o = 1; o < 64; o <<= 1) v += __shfl_xor(v, o);
    return v;
}

struct Args { const float* in[20]; float* out; unsigned char* ws; int ph_lo, ph_hi; };

template <int MODE>
__device__ __forceinline__ void p0_transpose_item(const float* W, int K, int N, bf16* WT, LAS float* scr, int item, int nblk, int lane) {
    const int kb = item / nblk, nb = item % nblk, k0 = 64 * kb, n0 = 32 * nb;
#pragma unroll 8
    for (int i = 0; i < 32; ++i) { const int kk = 2 * i + (lane >> 5); const int n = n0 + (lane & 31);
        scr[kk * 33 + (lane & 31)] = (n < N) ? W[(size_t)(k0 + kk) * N + n] : 0.f; }
    asm volatile("s_waitcnt lgkmcnt(0)" ::: "memory");
    const int c = lane & 7;
#pragma unroll
    for (int j = 0; j < 4; ++j) { const int nl = (lane >> 3) + 8 * j; const LAS float* s = scr + (8 * c) * 33 + nl;
        u32x4 o; o.x = pk2(s[0 * 33], s[1 * 33]); o.y = pk2(s[2 * 33], s[3 * 33]); o.z = pk2(s[4 * 33], s[5 * 33]); o.w = pk2(s[6 * 33], s[7 * 33]);
        int n = n0 + nl, dr = n;
        if (MODE == 1) { const int isg = n >= FF ? 1 : 0; const int jj = n - isg * FF; dr = (jj >> 7) * 256 + isg * 128 + (jj & 127); }
        *(u32x4*)(WT + (size_t)dr * K + k0 + 8 * c) = o; }
    asm volatile("s_waitcnt lgkmcnt(0)" ::: "memory");
}

__device__ __forceinline__ void p0_prep(const Args& a, LAS unsigned char* lds, int tid, int lane, int wave, int G) {
    unsigned char* ws = a.ws;
    {
        LAS float* scr = (LAS float*)(lds + wave * 16384);
        const int gw = blockIdx.x * NWAVES + wave, NGW = G * NWAVES;
        constexpr int I_IN = 16 * (NPROJ_PAD / 32), I_OUT = 16 * 32, I_UP = 16 * (NUP / 32), I_DN = (FF / 64) * 32;
        constexpr int NIT = I_IN + I_OUT + 2 * I_UP + 2 * I_DN;
        for (int it = gw; it < NIT; it += NGW) {
            int r = it;
            if (r < I_IN) { p0_transpose_item<0>(a.in[14], D, NPROJ, (bf16*)(ws + WS_WIN), scr, r, NPROJ_PAD / 32, lane); continue; } r -= I_IN;
            if (r < I_OUT) { p0_transpose_item<0>(a.in[17], D, D, (bf16*)(ws + WS_WOUT), scr, r, 32, lane); continue; } r -= I_OUT;
            if (r < I_UP) { p0_transpose_item<1>(a.in[10], D, NUP, (bf16*)(ws + WS_WUP), scr, r, NUP / 32, lane); continue; } r -= I_UP;
            if (r < I_UP) { p0_transpose_item<1>(a.in[10] + (size_t)D * NUP, D, NUP, (bf16*)(ws + WS_WUP) + (size_t)NUP * D, scr, r, NUP / 32, lane); continue; } r -= I_UP;
            if (r < I_DN) { p0_transpose_item<0>(a.in[13], FF, D, (bf16*)(ws + WS_WDN), scr, r, 32, lane); continue; } r -= I_DN;
            p0_transpose_item<0>(a.in[13] + (size_t)FF * D, FF, D, (bf16*)(ws + WS_WDN) + (size_t)D * FF, scr, r, 32, lane);
        }
    }
    __syncthreads();
    LAS float* tab = (LAS float*)(lds + 131072);
    for (int i = tid; i < 2048; i += NTHR) tab[i] = cospif((float)i * (1.0f / 1024.0f));
    __syncthreads();
    {
        bf16* DF = (bf16*)(ws + WS_DFT);
        const int total = 4096 * 256;
        for (int idx = blockIdx.x * NTHR + tid; idx < total; idx += G * NTHR) {
            const int r = idx >> 8, t0 = (idx & 255) * 8, tp = r & 2047, sh = (r >> 11) ? 512 : 0;
            float v[8];
#pragma unroll
            for (int j = 0; j < 8; ++j) v[j] = tab[(tp * (t0 + j) + sh) & 2047] * (1.0f / 512.0f);
            u32x4 o; o.x = pk2(v[0], v[1]); o.y = pk2(v[2], v[3]); o.z = pk2(v[4], v[5]); o.w = pk2(v[6], v[7]);
            *(u32x4*)(DF + (size_t)r * 2048 + t0) = o;
        }
    }
    {
        const float* W = a.in[18]; bf16* WCS = (bf16*)(ws + WS_WCS);
        LAS float* wt = (LAS float*)lds;
        for (int it = blockIdx.x; it < 8 * 16; it += G) {
            const int g = it >> 4, n0 = (it & 15) * 64;
            __syncthreads();
            for (int i = tid; i < 128 * 64; i += NTHR) wt[i] = W[(size_t)(g * 128 + (i >> 6)) * D + n0 + (i & 63)];
            __syncthreads();
            const int nl = tid >> 3, cgp = tid & 7;
            float ac[16], as[16];
#pragma unroll
            for (int j = 0; j < 16; ++j) { ac[j] = 0.f; as[j] = 0.f; }
            for (int cp = 0; cp < 128; ++cp) {
                const float w = wt[cp * 64 + nl];
#pragma unroll
                for (int j = 0; j < 16; ++j) { const int c = 16 * cgp + j; const int ph = (c * cp) & 127;
                    ac[j] += tab[ph * 16] * w; as[j] += tab[((ph * 16) + 1536) & 2047] * w; }
            }
            bf16* dst = WCS + (size_t)(n0 + nl) * 2048 + g * 128 + 16 * cgp;
            u32x4 o0, o1;
            o0.x = pk2(ac[0], ac[1]); o0.y = pk2(ac[2], ac[3]); o0.z = pk2(ac[4], ac[5]); o0.w = pk2(ac[6], ac[7]);
            o1.x = pk2(ac[8], ac[9]); o1.y = pk2(ac[10], ac[11]); o1.z = pk2(ac[12], ac[13]); o1.w = pk2(ac[14], ac[15]);
            *(u32x4*)dst = o0; *(u32x4*)(dst + 8) = o1;
            o0.x = pk2(as[0], as[1]); o0.y = pk2(as[2], as[3]); o0.z = pk2(as[4], as[5]); o0.w = pk2(as[6], as[7]);
            o1.x = pk2(as[8], as[9]); o1.y = pk2(as[10], as[11]); o1.z = pk2(as[12], as[13]); o1.w = pk2(as[14], as[15]);
            *(u32x4*)(dst + 1024) = o0; *(u32x4*)(dst + 1024 + 8) = o1;
        }
    }
    __syncthreads();
    {
        LAS float* sc = (LAS float*)lds;
        LAS float* red = (LAS float*)(lds + 40960);
        for (int i = tid; i < 9 * 1024; i += NTHR) { const float v = (i < 8 * 1024) ? a.in[1][i] : a.in[3][i - 8 * 1024]; sc[i] = silu_f(v); }
        __syncthreads();
        float* MOD = (float*)(ws + WS_MOD);
        for (int it = blockIdx.x; it < 2 * 96; it += G) {
            const int l = it / 96, c0 = (it % 96) * 64;
            const float* Wl = a.in[4] + (size_t)l * D * 6144 + c0 + lane;
            float acc[9];
#pragma unroll
            for (int r = 0; r < 9; ++r) acc[r] = 0.f;
            const int kb = wave * 128;
#pragma unroll 4
            for (int k = 0; k < 128; ++k) { const float w = Wl[(size_t)(kb + k) * 6144];
#pragma unroll
                for (int r = 0; r < 9; ++r) acc[r] += sc[r * 1024 + kb + k] * w; }
#pragma unroll
            for (int r = 0; r < 9; ++r) red[(wave * 9 + r) * 64 + lane] = acc[r];
            __syncthreads();
            for (int i = tid; i < 9 * 64; i += NTHR) { float s = 0.f;
#pragma unroll
                for (int w = 0; w < 8; ++w) s += red[w * 576 + i];
                const int r = i >> 6, cl = i & 63;
                MOD[((size_t)l * 9 + r) * 6144 + c0 + cl] = s + a.in[5][(size_t)l * 6144 + c0 + cl]; }
            __syncthreads();
        }
    }
}

__device__ __forceinline__ void load_row_f32(const float* p, int lane, f32x4 (&v)[4]) {
#pragma unroll
    for (int j = 0; j < 4; ++j) v[j] = *(const f32x4*)(p + 4 * lane + 256 * j);
}
__device__ __forceinline__ float row_sumsq(const f32x4 (&v)[4]) {
    float s = 0.f;
#pragma unroll
    for (int j = 0; j < 4; ++j) s += (v[j].x * v[j].x + v[j].y * v[j].y) + (v[j].z * v[j].z + v[j].w * v[j].w);
    return wave_sum(s);
}

__device__ __forceinline__ void p1_norm_mod(const Args& a, int lane, int wave, int G) {
    const float* MOD = (const float*)(a.ws + WS_MOD);
    bf16* A = (bf16*)(a.ws + WS_A);
    const float* g = a.in[6];
    const int gw = blockIdx.x * NWAVES + wave, NGW = G * NWAVES;
    for (int m = gw; m < MALL; m += NGW) {
        const float* xr = (m < ML) ? a.in[0] + (size_t)m * D : a.in[2] + (size_t)(m - ML) * D;
        const int mr = (m < ML) ? (m >> 11) : 8;
        const float* sh = MOD + (size_t)mr * 6144, * sc = sh + D;
        f32x4 v[4]; load_row_f32(xr, lane, v);
        const float rs = rsqrtf(row_sumsq(v) * (1.f / D) + EPS);
#pragma unroll
        for (int j = 0; j < 4; ++j) { const int c = 4 * lane + 256 * j;
            const f32x4 gg = *(const f32x4*)(g + c), s1 = *(const f32x4*)(sc + c), s0 = *(const f32x4*)(sh + c);
            const f32x4 h = v[j] * rs * gg * (1.f + s1) + s0;
            u32x2 o; o.x = pk2(h.x, h.y); o.y = pk2(h.z, h.w);
            *(u32x2*)(A + (size_t)m * D + c) = o; }
    }
}

__device__ __forceinline__ void p4_readout(const Args& a, int lane, int wave, int G) {
    const bf16* HF = (const bf16*)(a.ws + WS_HF); const bf16* HB = (const bf16*)(a.ws + WS_HB); const bf16* O = (const bf16*)(a.ws + WS_O);
    bf16* Y = (bf16*)(a.ws + WS_Y); const float* ng = a.in[16];
    const int gw = blockIdx.x * NWAVES + wave, NGW = G * NWAVES;
    for (int m = gw; m < ML; m += NGW) {
        const size_t off = (size_t)m * D + 16 * lane;
        const u32x4 f0 = *(const u32x4*)(HF + off), f1 = *(const u32x4*)(HF + off + 8);
        const u32x4 b0 = *(const u32x4*)(HB + off), b1 = *(const u32x4*)(HB + off + 8);
        const u32x4 o0 = *(const u32x4*)(O + off), o1 = *(const u32x4*)(O + off + 8);
        float h[16], og[16];
        const unsigned fw[8] = {f0.x, f0.y, f0.z, f0.w, f1.x, f1.y, f1.z, f1.w};
        const unsigned bw[8] = {b0.x, b0.y, b0.z, b0.w, b1.x, b1.y, b1.z, b1.w};
        const unsigned ow[8] = {o0.x, o0.y, o0.z, o0.w, o1.x, o1.y, o1.z, o1.w};
        float ss = 0.f;
#pragma unroll
        for (int j = 0; j < 8; ++j) {
            h[2 * j] = bf2f(fw[j] & 0xffffu) + bf2f(bw[j] & 0xffffu); h[2 * j + 1] = bf2f(fw[j] >> 16) + bf2f(bw[j] >> 16);
            og[2 * j] = bf2f(ow[j] & 0xffffu); og[2 * j + 1] = bf2f(ow[j] >> 16);
            ss += h[2 * j] * h[2 * j] + h[2 * j + 1] * h[2 * j + 1]; }
        ss += __shfl_xor(ss, 1); ss += __shfl_xor(ss, 2); ss += __shfl_xor(ss, 4); ss += __shfl_xor(ss, 8);
        const float rs = rsqrtf(ss * (1.f / DV) + EPS);
        unsigned w[8];
#pragma unroll
        for (int j = 0; j < 8; ++j) {
            const float y0 = h[2 * j] * rs * ng[16 * lane + 2 * j] * sigmoid_f(og[2 * j]);
            const float y1 = h[2 * j + 1] * rs * ng[16 * lane + 2 * j + 1] * sigmoid_f(og[2 * j + 1]);
            w[j] = pk2(y0, y1); }
        *(u32x4*)(Y + off) = (u32x4){w[0], w[1], w[2], w[3]}; *(u32x4*)(Y + off + 8) = (u32x4){w[4], w[5], w[6], w[7]};
    }
}

template <int NEXT>
__device__ __forceinline__ void rowpass(const float* Y, const float* xin, float* xout, const float* gate  , const float* post_g,
                                        const float* ng, const float* shp, const float* scp, bf16* Hout, int lane, int wave, int G) {
    const int gw = blockIdx.x * NWAVES + wave, NGW = G * NWAVES;
    for (int m = gw; m < ML; m += NGW) {
        const int b = m >> 11;
        f32x4 y[4], x[4]; load_row_f32(Y + (size_t)m * D, lane, y); load_row_f32(xin + (size_t)m * D, lane, x);
        const float rs = rsqrtf(row_sumsq(y) * (1.f / D) + EPS);
#pragma unroll
        for (int j = 0; j < 4; ++j) { const int c = 4 * lane + 256 * j;
            const f32x4 gt = *(const f32x4*)(gate + (size_t)b * 6144 + c), pg = *(const f32x4*)(post_g + c);
            x[j] = x[j] + gt * (y[j] * rs * pg);
            *(f32x4*)(xout + (size_t)m * D + c) = x[j]; }
        if (NEXT == 1) {
            const float rs2 = rsqrtf(row_sumsq(x) * (1.f / D) + EPS);
#pragma unroll
            for (int j = 0; j < 4; ++j) { const int c = 4 * lane + 256 * j;
                const f32x4 gg = *(const f32x4*)(ng + c), s1 = *(const f32x4*)(scp + (size_t)b * 6144 + c), s0 = *(const f32x4*)(shp + (size_t)b * 6144 + c);
                const f32x4 h = x[j] * rs2 * gg * (1.f + s1) + s0;
                u32x2 o; o.x = pk2(h.x, h.y); o.y = pk2(h.z, h.w);
                *(u32x2*)(Hout + (size_t)m * D + c) = o; }
        }
    }
}
__device__ __forceinline__ void rowpass_t(const float* Y, const float* xin, float* xout, const float* gate, const float* post_g,
                                          const float* ng, const float* shp, const float* scp, bf16* HT, LAS unsigned char* lds, int tid, int lane, int wave, int G) {
    constexpr int PITCH = 1024 + 8;
    LAS bf16* tile = (LAS bf16*)lds;
    for (int it = blockIdx.x; it < ML / 64; it += G) {
        const int m0 = it * 64, b = m0 >> 11, t0 = m0 & 2047;
        __syncthreads();
        for (int rr = 0; rr < 8; ++rr) {
            const int r = wave * 8 + rr, m = m0 + r;
            f32x4 y[4], x[4]; load_row_f32(Y + (size_t)m * D, lane, y); load_row_f32(xin + (size_t)m * D, lane, x);
            const float rs = rsqrtf(row_sumsq(y) * (1.f / D) + EPS);
#pragma unroll
            for (int j = 0; j < 4; ++j) { const int c = 4 * lane + 256 * j;
                const f32x4 gt = *(const f32x4*)(gate + (size_t)b * 6144 + c), pg = *(const f32x4*)(post_g + c);
                x[j] = x[j] + gt * (y[j] * rs * pg);
                *(f32x4*)(xout + (size_t)m * D + c) = x[j]; }
            const float rs2 = rsqrtf(row_sumsq(x) * (1.f / D) + EPS);
#pragma unroll
            for (int j = 0; j < 4; ++j) { const int c = 4 * lane + 256 * j;
                const f32x4 gg = *(const f32x4*)(ng + c), s1 = *(const f32x4*)(scp + (size_t)b * 6144 + c), s0 = *(const f32x4*)(shp + (size_t)b * 6144 + c);
                const f32x4 h = x[j] * rs2 * gg * (1.f + s1) + s0;
                u32x2 o; o.x = pk2(h.x, h.y); o.y = pk2(h.z, h.w);
                *(LAS u32x2*)(tile + r * PITCH + c) = o; }
        }
        __syncthreads();
        unsigned lo[32], hi[32];
#pragma unroll
        for (int t = 0; t < 64; t += 2) {
            const unsigned w0 = *(const LAS unsigned*)(tile + t * PITCH + 2 * tid), w1 = *(const LAS unsigned*)(tile + (t + 1) * PITCH + 2 * tid);
            lo[t >> 1] = (w0 & 0xffffu) | (w1 << 16); hi[t >> 1] = (w0 >> 16) | (w1 & 0xffff0000u); }
        bf16* d0 = HT + ((size_t)b * D + 2 * tid) * T + t0; bf16* d1 = d0 + T;
#pragma unroll
        for (int q = 0; q < 8; ++q) { *(u32x4*)(d0 + 8 * q) = (u32x4){lo[4 * q], lo[4 * q + 1], lo[4 * q + 2], lo[4 * q + 3]};
                                      *(u32x4*)(d1 + 8 * q) = (u32x4){hi[4 * q], hi[4 * q + 1], hi[4 * q + 2], hi[4 * q + 3]}; }
    }
}

__device__ __forceinline__ void ngemm_tile(const bf16* A, int lda, const bf16* Bt, int ldb, int K, LAS float* sA, LAS float* sB, int tid, float (&acc)[4][4]) {
#pragma unroll
    for (int i = 0; i < 4; ++i)
#pragma unroll
        for (int j = 0; j < 4; ++j) acc[i][j] = 0.f;
    const int ty = tid >> 4, tx = tid & 15;
    for (int k0 = 0; k0 < K; k0 += 32) {
        { const u32x4 v = *(const u32x4*)(A + (size_t)(tid >> 2) * lda + k0 + (tid & 3) * 8);
          LAS float* d = sA + (tid >> 2) * 33 + (tid & 3) * 8;
          d[0] = bf2f(v.x & 0xffffu); d[1] = bf2f(v.x >> 16); d[2] = bf2f(v.y & 0xffffu); d[3] = bf2f(v.y >> 16);
          d[4] = bf2f(v.z & 0xffffu); d[5] = bf2f(v.z >> 16); d[6] = bf2f(v.w & 0xffffu); d[7] = bf2f(v.w >> 16); }
        { const u32x2 v = *(const u32x2*)(Bt + (size_t)(tid >> 3) * ldb + k0 + (tid & 7) * 4);
          LAS float* d = sB + (tid >> 3) * 33 + (tid & 7) * 4;
          d[0] = bf2f(v.x & 0xffffu); d[1] = bf2f(v.x >> 16); d[2] = bf2f(v.y & 0xffffu); d[3] = bf2f(v.y >> 16); }
        __syncthreads();
#pragma unroll 8
        for (int k = 0; k < 32; ++k) {
            float av[4], bv[4];
#pragma unroll
            for (int i = 0; i < 4; ++i) { av[i] = sA[(4 * ty + i) * 33 + k]; bv[i] = sB[(4 * tx + i) * 33 + k]; }
#pragma unroll
            for (int i = 0; i < 4; ++i)
#pragma unroll
                for (int j = 0; j < 4; ++j) acc[i][j] += av[i] * bv[j];
        }
        __syncthreads();
    }
}

__device__ __forceinline__ void p2_inproj_simple(const Args& a, LAS unsigned char* lds, int tid, int G) {
    LAS float* sA = (LAS float*)lds; LAS float* sB = sA + 128 * 33;
    const bf16* A = (const bf16*)(a.ws + WS_A); const bf16* W = (const bf16*)(a.ws + WS_WIN);
    bf16* Q = (bf16*)(a.ws + WS_Q); bf16* Kb = (bf16*)(a.ws + WS_K); bf16* V = (bf16*)(a.ws + WS_V); bf16* O = (bf16*)(a.ws + WS_O); float* Gt = (float*)(a.ws + WS_G);
    const float* bias = a.in[15];
    constexpr int NCB = 49;
    const int ty = tid >> 4, tx = tid & 15;
    for (int it = blockIdx.x; it < (MALL / 128) * NCB; it += G) {
        const int rt = it / NCB, cb = it % NCB, row0 = rt * 128, col0 = cb * 64;
        float acc[4][4];
        ngemm_tile(A + (size_t)row0 * D, D, W + (size_t)col0 * D, D, D, sA, sB, tid, acc);
#pragma unroll
        for (int i = 0; i < 4; ++i)
#pragma unroll
            for (int j = 0; j < 4; ++j) {
                const int r = row0 + 4 * ty + i, c = col0 + 4 * tx + j;
                if (c >= NPROJ) continue;
                const float v = acc[i][j] + bias[c];
                if (c < 512) { if (r < ML) Q[(size_t)r * 512 + c] = (bf16)f2bf(v); }
                else if (c < 1024) Kb[(size_t)r * 512 + (c - 512)] = (bf16)f2bf(v * 0.08838834764831845f);
                else if (c < 2048) V[(size_t)r * D + (c - 1024)] = (bf16)f2bf(v);
                else if (c < 3072) { if (r < ML) O[(size_t)r * D + (c - 2048)] = (bf16)f2bf(v); }
                else Gt[(size_t)r * 16 + (c - 3072)] = v;
            }
    }
}

__device__ __forceinline__ void gemm_simple_f32(const bf16* A, int lda, const bf16* Bt, int ldb, int M, int N, int K, float* C, int ldc, const float* bias, LAS unsigned char* lds, int tid, int G) {
    LAS float* sA = (LAS float*)lds; LAS float* sB = sA + 128 * 33;
    const int ty = tid >> 4, tx = tid & 15, ncb = N / 64;
    for (int it = blockIdx.x; it < (M / 128) * ncb; it += G) {
        const int rt = it / ncb, cb = it % ncb, row0 = rt * 128, col0 = cb * 64;
        float acc[4][4];
        ngemm_tile(A + (size_t)row0 * lda, lda, Bt + (size_t)col0 * ldb, ldb, K, sA, sB, tid, acc);
#pragma unroll
        for (int i = 0; i < 4; ++i) { f32x4 o = {acc[i][0], acc[i][1], acc[i][2], acc[i][3]};
            if (bias) o = o + *(const f32x4*)(bias + col0 + 4 * tx);
            *(f32x4*)(C + (size_t)(row0 + 4 * ty + i) * ldc + col0 + 4 * tx) = o; }
    }
}

__device__ __forceinline__ void p7_up_simple(const bf16* A, const bf16* W  , const float* cw  , const float* cb, bf16* ACT, LAS unsigned char* lds, int tid, int G) {
    LAS float* sA = (LAS float*)lds; LAS float* sB = sA + 128 * 33; LAS float* gs = sB + 64 * 33;
    const int ty = tid >> 4, tx = tid & 15;
    constexpr int NCB = FF / 64;
    for (int it = blockIdx.x; it < (ML / 128) * NCB; it += G) {
        const int rt = it / NCB, jb = it % NCB, row0 = rt * 128, j0 = jb * 64;
        const int wrow = (jb >> 1) * 256 + (jb & 1) * 64;
        float u[4][4], g[4][4];
        ngemm_tile(A + (size_t)row0 * D, D, W + (size_t)wrow * D, D, D, sA, sB, tid, u);
        ngemm_tile(A + (size_t)row0 * D, D, W + (size_t)(wrow + 128) * D, D, D, sA, sB, tid, g);
#pragma unroll
        for (int i = 0; i < 4; ++i)
#pragma unroll
            for (int j = 0; j < 4; ++j) gs[(4 * ty + i) * 65 + 4 * tx + j] = g[i][j];
        __syncthreads();
#pragma unroll
        for (int i = 0; i < 4; ++i)
#pragma unroll
            for (int j = 0; j < 4; ++j) {
                const int rl = 4 * ty + i, cl = 4 * tx + j, f = j0 + cl;
                const float gm = (rl & 63) ? gs[(rl - 1) * 65 + cl] : 0.f, gp = ((rl & 63) != 63) ? gs[(rl + 1) * 65 + cl] : 0.f;
                const float gc = gm * cw[f] + g[i][j] * cw[FF + f] + gp * cw[2 * FF + f] + cb[f];
                ACT[(size_t)(row0 + rl) * FF + f] = (bf16)f2bf(silu_f(gc) * u[i][j]);
            }
        __syncthreads();
    }
}

__device__ __forceinline__ void p10_seqmix_simple(const Args& a, LAS unsigned char* lds, int tid, int G) {
    LAS float* sA = (LAS float*)lds; LAS float* sB = sA + 128 * 33;
    const bf16* DF = (const bf16*)(a.ws + WS_DFT); const bf16* HT = (const bf16*)(a.ws + WS_HT); bf16* PQ = (bf16*)(a.ws + WS_PQ);
    const int ty = tid >> 4, tx = tid & 15;
    for (int it = blockIdx.x; it < 8 * 32 * 16; it += G) {
        const int b = it >> 9, rt = (it >> 4) & 31, cbk = it & 15, r0 = rt * 128, c0 = cbk * 64;
        float acc[4][4];
        ngemm_tile(DF + (size_t)r0 * 2048, 2048, HT + ((size_t)b * D + c0) * T, T, 2048, sA, sB, tid, acc);
        const int kind = r0 >> 11, tp0 = r0 & 2047;
#pragma unroll
        for (int i = 0; i < 4; ++i) { u32x2 o; o.x = pk2(acc[i][0], acc[i][1]); o.y = pk2(acc[i][2], acc[i][3]);
            *(u32x2*)(PQ + (size_t)(b * 2048 + tp0 + 4 * ty + i) * 2048 + kind * 1024 + c0 + 4 * tx) = o; }
    }
}

__device__ __forceinline__ void p3_mlstm_simple(const Args& a, LAS unsigned char* lds, int tid, int G) {
    const bf16* Q = (const bf16*)(a.ws + WS_Q); const bf16* Kb = (const bf16*)(a.ws + WS_K); const bf16* V = (const bf16*)(a.ws + WS_V); const float* Gt = (const float*)(a.ws + WS_G);
    LAS float* sq = (LAS float*)lds;
    LAS float* sk = sq + 64 * 128;
    LAS float* sv = sk + 64 * 128;
    LAS float* sg = sv + 64 * 32;
    const int j = tid >> 4, g = tid & 15;
    for (int it = blockIdx.x; it < 64 * 8; it += G) {
        const int bh = it >> 4, dir = (it >> 3) & 1, dvb = it & 7, b = bh >> 2, h = bh & 3;
        bf16* Hout = (bf16*)(a.ws + (dir ? WS_HB : WS_HF));
        float Cst[8], nst[8];
#pragma unroll
        for (int d = 0; d < 8; ++d) { Cst[d] = 0.f; nst[d] = 0.f; }
        for (int sb = 0; sb < 36; ++sb) {
            const bool isctx = sb < 4;
            const int nblk = isctx ? 4 : 32, bi = isctx ? sb : sb - 4;
            const int blk = dir ? (nblk - 1 - bi) : bi;
            const int rowbase = isctx ? (ML + b * TC + blk * 64) : (b * T + blk * 64);
            __syncthreads();
            for (int i = tid; i < 64 * 128; i += NTHR) { const int p = i >> 7, c = i & 127; const int tok = rowbase + (dir ? 63 - p : p);
                sk[i] = bf2f(Kb[(size_t)tok * 512 + h * 128 + c]);
                sq[i] = isctx ? 0.f : bf2f(Q[(size_t)tok * 512 + h * 128 + c]); }
            for (int i = tid; i < 64 * 32; i += NTHR) { const int p = i >> 5, c = i & 31; const int tok = rowbase + (dir ? 63 - p : p);
                sv[i] = bf2f(V[(size_t)tok * D + h * 256 + dvb * 32 + c]); }
            if (tid < 64) { const int tok = rowbase + (dir ? 63 - tid : tid);
                sg[2 * tid] = __expf(Gt[(size_t)tok * 16 + dir * 8 + h]); sg[2 * tid + 1] = __expf(logsigmoid_f(Gt[(size_t)tok * 16 + dir * 8 + 4 + h])); }
            __syncthreads();
            for (int p = 0; p < 64; ++p) {
                const float iv = sg[2 * p], fv = sg[2 * p + 1], vv = sv[p * 32 + j];
                float pn = 0.f, pd = 0.f;
#pragma unroll
                for (int d = 0; d < 8; ++d) { const float kk = sk[p * 128 + 8 * g + d], qq = sq[p * 128 + 8 * g + d];
                    Cst[d] = fv * Cst[d] + iv * kk * vv; nst[d] = fv * nst[d] + iv * kk;
                    pn += qq * Cst[d]; pd += qq * nst[d]; }
                if (!isctx) {
                    pn += __shfl_xor(pn, 1); pn += __shfl_xor(pn, 2); pn += __shfl_xor(pn, 4); pn += __shfl_xor(pn, 8);
                    pd += __shfl_xor(pd, 1); pd += __shfl_xor(pd, 2); pd += __shfl_xor(pd, 4); pd += __shfl_xor(pd, 8);
                    if (g == 0) { const int tok = rowbase + (dir ? 63 - p : p);
                        Hout[(size_t)tok * D + h * 256 + dvb * 32 + j] = (bf16)f2bf(pn / fmaxf(fabsf(pd), 1.0f)); }
                }
            }
        }
    }
}


namespace ml {
typedef short bf16x8 __attribute__((ext_vector_type(8)));
typedef short s16x4 __attribute__((ext_vector_type(4)));
constexpr int L_K = 0, L_V = 32768, L_VS = 49152, L_CT = 65536, L_ST = 86016, L_G = 102400, G_STRIDE = 3072;
__device__ __forceinline__ unsigned off_b(unsigned row, unsigned ch) { return 256u * row + 16u * (ch ^ (((row & 3) << 2) | ((row >> 2) & 3))); }
__device__ __forceinline__ unsigned off_v(unsigned row, unsigned c32) { return 128u * row + 32u * (c32 ^ (((row >> 1) & 1) | (((row >> 3) & 1) << 1))); }
__device__ __forceinline__ bf16x8 tr8_b(LAS unsigned char* img, int lane, int c, int ks) {
    const unsigned g = lane >> 4, q = (lane & 15) >> 2, p = lane & 3;
    const s16x4 lo = __builtin_amdgcn_ds_read_tr16_b64_v4i16((LAS s16x4*)(img + off_b(32 * ks + 8 * g + q, 2 * c + (p >> 1)) + 8 * (p & 1)));
    const s16x4 hi = __builtin_amdgcn_ds_read_tr16_b64_v4i16((LAS s16x4*)(img + off_b(32 * ks + 8 * g + 4 + q, 2 * c + (p >> 1)) + 8 * (p & 1)));
    return __builtin_shufflevector(lo, hi, 0, 1, 2, 3, 4, 5, 6, 7);
}
__device__ __forceinline__ bf16x8 tr8_v(LAS unsigned char* img, int lane, int c, int ks) {
    const unsigned g = lane >> 4, q = (lane & 15) >> 2, p = lane & 3;
    const s16x4 lo = __builtin_amdgcn_ds_read_tr16_b64_v4i16((LAS s16x4*)(img + off_v(32 * ks + 8 * g + q, c) + 8 * p));
    const s16x4 hi = __builtin_amdgcn_ds_read_tr16_b64_v4i16((LAS s16x4*)(img + off_v(32 * ks + 8 * g + 4 + q, c) + 8 * p));
    return __builtin_shufflevector(lo, hi, 0, 1, 2, 3, 4, 5, 6, 7);
}
__device__ __forceinline__ unsigned cvt_pk(float lo, float hi) { unsigned r; asm volatile("v_cvt_pk_bf16_f32 %0, %1, %2" : "=v"(r) : "v"(lo), "v"(hi)); return r; }

__device__ __forceinline__ void mlstm_phase(const Args& a, LAS unsigned char* lds, int tid, int lane, int wave, int G) {
    const bf16* Qg = (const bf16*)(a.ws + WS_Q); const bf16* Kg = (const bf16*)(a.ws + WS_K); const bf16* Vg = (const bf16*)(a.ws + WS_V); const float* Gt = (const float*)(a.ws + WS_G);
    const int fr = lane & 15, fq = lane >> 4;
    const int vcu = (G % 8 == 0) ? ((int)blockIdx.x % 8) * (G / 8) + (int)blockIdx.x / 8 : (int)blockIdx.x;
    for (int it = vcu; it < 256; it += G) {
        const int dvq = it & 3, dir = (it >> 2) & 1, bh = it >> 3, b = bh >> 2, h = bh & 3;
        bf16* Hout = (bf16*)(a.ws + (dir ? WS_HB : WS_HF));
        auto chunk_base = [&](int ci) -> int { return ci < 2 ? (ML + b * TC + (dir ? 1 - ci : ci) * 128) : (b * T + (dir ? 15 - (ci - 2) : (ci - 2)) * 128); };
        __syncthreads();
        for (int i = tid; i < 20480 / 16; i += NTHR) *(LAS u32x4*)(lds + L_CT + 16 * i) = (u32x4){0u, 0u, 0u, 0u};
        f32x4 cacc[5];
#pragma unroll
        for (int t5 = 0; t5 < 5; ++t5) cacc[t5] = (f32x4){0.f, 0.f, 0.f, 0.f};
        float mstate = 0.f;
        u32x4 kreg[4], vreg[2]; bf16x8 qf[4], qn[4];
#pragma unroll
        for (int i = 0; i < 4; ++i) { qf[i] = (bf16x8){0, 0, 0, 0, 0, 0, 0, 0}; qn[i] = qf[i]; }

        auto gate_scan = [&](int ci) {
            const int base = chunk_base(ci);
            LAS float* gb = (LAS float*)(lds + L_G + (ci & 1) * G_STRIDE);
            const int r0 = lane, r1 = lane + 64;
            const int t0 = base + (dir ? 127 - r0 : r0), t1 = base + (dir ? 127 - r1 : r1);
            const float li0 = Gt[(size_t)t0 * 16 + dir * 8 + h], li1 = Gt[(size_t)t1 * 16 + dir * 8 + h];
            float s0 = logsigmoid_f(Gt[(size_t)t0 * 16 + dir * 8 + 4 + h]), s1 = logsigmoid_f(Gt[(size_t)t1 * 16 + dir * 8 + 4 + h]);
#pragma unroll
            for (int d = 1; d < 64; d <<= 1) { const float x0 = __shfl_up(s0, d), x1 = __shfl_up(s1, d); if (lane >= d) { s0 += x0; s1 += x1; } }
            s1 += __shfl(s0, 63);
            const float u0 = li0 - s0, u1 = li1 - s1;
            float c0 = u0, c1 = u1;
#pragma unroll
            for (int d = 1; d < 64; d <<= 1) { const float x0 = __shfl_up(c0, d), x1 = __shfl_up(c1, d); if (lane >= d) { c0 = fmaxf(c0, x0); c1 = fmaxf(c1, x1); } }
            c1 = fmaxf(c1, __shfl(c0, 63));
            const float m = mstate, M0 = fmaxf(m, c0), M1 = fmaxf(m, c1), MLs = __shfl(M1, 63), bL = __shfl(s1, 63);
            gb[r0] = u0; gb[r1] = u1; gb[128 + r0] = M0; gb[128 + r1] = M1;
            gb[256 + r0] = __expf(-(s0 + M0)); gb[256 + r1] = __expf(-(s1 + M1));
            gb[384 + r0] = __expf(u0 - MLs); gb[384 + r1] = __expf(u1 - MLs);
            gb[512 + r0] = __expf(m - M0); gb[512 + r1] = __expf(m - M1);
            if (lane == 0) gb[640] = __expf(m - MLs);
            mstate = bL + MLs;
        };
        auto prefetch = [&](int ci) {
            const int base = chunk_base(ci);
#pragma unroll
            for (int i = 0; i < 4; ++i) { const int p = tid + 512 * i, row = p >> 4, ch = p & 15; const int tok = base + (dir ? 127 - row : row);
                kreg[i] = *(const u32x4*)(Kg + (size_t)tok * 512 + h * 128 + ch * 8); }
#pragma unroll
            for (int i = 0; i < 2; ++i) { const int p = tid + 512 * i, row = p >> 3, c8 = p & 7; const int tok = base + (dir ? 127 - row : row);
                vreg[i] = *(const u32x4*)(Vg + (size_t)tok * D + h * 256 + dvq * 64 + c8 * 8); }
        };
        auto prefetch_q = [&](int ci) {
            const int base = chunk_base(ci); const int t = 16 * wave + fr; const int tok = base + (dir ? 127 - t : t);
#pragma unroll
            for (int ks = 0; ks < 4; ++ks) qn[ks] = *(const bf16x8*)(Qg + (size_t)tok * 512 + h * 128 + 32 * ks + 8 * fq);
        };
        auto stage = [&](int ci) {
            const LAS float* gb = (const LAS float*)(lds + L_G + (ci & 1) * G_STRIDE);
#pragma unroll
            for (int i = 0; i < 4; ++i) { const int p = tid + 512 * i, row = p >> 4, ch = p & 15; *(LAS u32x4*)(lds + L_K + off_b(row, ch)) = kreg[i]; }
#pragma unroll
            for (int i = 0; i < 2; ++i) { const int p = tid + 512 * i, row = p >> 3, c8 = p & 7; const unsigned o = off_v(row, c8 >> 1) + (c8 & 1) * 16;
                *(LAS u32x4*)(lds + L_V + o) = vreg[i];
                const float w = gb[384 + row]; const u32x4 v = vreg[i]; u32x4 sv;
                sv.x = cvt_pk(bf2f(v.x & 0xffffu) * w, bf2f(v.x >> 16) * w); sv.y = cvt_pk(bf2f(v.y & 0xffffu) * w, bf2f(v.y >> 16) * w);
                sv.z = cvt_pk(bf2f(v.z & 0xffffu) * w, bf2f(v.z >> 16) * w); sv.w = cvt_pk(bf2f(v.w & 0xffffu) * w, bf2f(v.w >> 16) * w);
                *(LAS u32x4*)(lds + L_VS + o) = sv; }
        };

        prefetch(0);
        if (wave == 0) gate_scan(0);
        __syncthreads();
        stage(0);
        __syncthreads();

        for (int ci = 0; ci < 18; ++ci) {
            const bool latent = ci >= 2, has_next = ci < 17;
            const LAS float* gb = (const LAS float*)(lds + L_G + (ci & 1) * G_STRIDE);
            if (has_next) { prefetch(ci + 1); if (ci + 1 >= 2) prefetch_q(ci + 1); }
            if (wave == 0 && has_next) gate_scan(ci + 1);
            if (latent) {
                const int t = 16 * wave + fr;
                const float Mt = gb[128 + t], wit = gb[512 + t], flt = gb[256 + t];
                f32x4 acc[5];
#pragma unroll
                for (int t5 = 0; t5 < 5; ++t5) acc[t5] = (f32x4){0.f, 0.f, 0.f, 0.f};
#pragma unroll
                for (int ks = 0; ks < 4; ++ks)
#pragma unroll
                    for (int t5 = 0; t5 < 5; ++t5) { const bf16x8 cf = *(const LAS bf16x8*)(lds + L_CT + off_b(fr + 16 * t5, 4 * ks + fq));
                        acc[t5] = __builtin_amdgcn_mfma_f32_16x16x32_bf16(cf, qf[ks], acc[t5], 0, 0, 0); }
#pragma unroll
                for (int t5 = 0; t5 < 5; ++t5) acc[t5] = acc[t5] * wit;
                for (int jp = 0; jp <= (wave >> 1); ++jp) {
                    f32x4 s_lo = {0.f, 0.f, 0.f, 0.f}, s_hi = {0.f, 0.f, 0.f, 0.f};
                    const int krow = 32 * jp + 8 * (fr >> 2) + (fr & 3);
#pragma unroll
                    for (int ks = 0; ks < 4; ++ks) {
                        const bf16x8 k_lo = *(const LAS bf16x8*)(lds + L_K + off_b(krow, 4 * ks + fq)), k_hi = *(const LAS bf16x8*)(lds + L_K + off_b(krow + 4, 4 * ks + fq));
                        s_lo = __builtin_amdgcn_mfma_f32_16x16x32_bf16(k_lo, qf[ks], s_lo, 0, 0, 0);
                        s_hi = __builtin_amdgcn_mfma_f32_16x16x32_bf16(k_hi, qf[ks], s_hi, 0, 0, 0);
                    }
                    const int sb = 32 * jp + 8 * fq;
                    const f32x4 u_lo = *(const LAS f32x4*)(gb + sb), u_hi = *(const LAS f32x4*)(gb + sb + 4);
                    float pv[8];
#pragma unroll
                    for (int e = 0; e < 4; ++e) { pv[e] = (sb + e <= t) ? s_lo[e] * __expf(u_lo[e] - Mt) : 0.f; pv[4 + e] = (sb + 4 + e <= t) ? s_hi[e] * __expf(u_hi[e] - Mt) : 0.f; }
                    u32x4 pw; pw.x = cvt_pk(pv[0], pv[1]); pw.y = cvt_pk(pv[2], pv[3]); pw.z = cvt_pk(pv[4], pv[5]); pw.w = cvt_pk(pv[6], pv[7]);
                    const bf16x8 sfrag = __builtin_bit_cast(bf16x8, pw);
#pragma unroll
                    for (int t5 = 0; t5 < 4; ++t5) { const bf16x8 vf = tr8_v(lds + L_V, lane, t5, jp); acc[t5] = __builtin_amdgcn_mfma_f32_16x16x32_bf16(vf, sfrag, acc[t5], 0, 0, 0); }
                    const short one = (fr == 0) ? (short)0x3F80 : (short)0;
                    const bf16x8 of = {one, one, one, one, one, one, one, one};
                    acc[4] = __builtin_amdgcn_mfma_f32_16x16x32_bf16(of, sfrag, acc[4], 0, 0, 0);
                }
                const float den = __shfl(acc[4][0], fr);
                const float inv = 1.0f / fmaxf(fabsf(den), flt);
#pragma unroll
                for (int t5 = 0; t5 < 4; ++t5) { u32x2 o; o.x = cvt_pk(acc[t5][0] * inv, acc[t5][1] * inv); o.y = cvt_pk(acc[t5][2] * inv, acc[t5][3] * inv);
                    *(LAS u32x2*)(lds + L_ST + t * 128 + (16 * t5 + 4 * fq) * 2) = o; }
                asm volatile("s_waitcnt lgkmcnt(0)" ::: "memory");
                { const int row = 16 * wave + (lane >> 2), cb = (lane & 3) * 32; const int base = chunk_base(ci); const int tok = base + (dir ? 127 - row : row);
                  const u32x4 o0 = *(const LAS u32x4*)(lds + L_ST + row * 128 + cb), o1 = *(const LAS u32x4*)(lds + L_ST + row * 128 + cb + 16);
                  bf16* dst = Hout + (size_t)tok * D + h * 256 + dvq * 64 + (lane & 3) * 16;
                  *(u32x4*)dst = o0; *(u32x4*)(dst + 8) = o1; }
            }
            if (has_next) {
                const float av = gb[640];
#pragma unroll
                for (int t5 = 0; t5 < 5; ++t5) cacc[t5] = cacc[t5] * av;
#pragma unroll
                for (int ks = 0; ks < 4; ++ks) {
                    const bf16x8 kt = tr8_b(lds + L_K, lane, wave, ks);
#pragma unroll
                    for (int t5 = 0; t5 < 4; ++t5) { const bf16x8 vs = tr8_v(lds + L_VS, lane, t5, ks); cacc[t5] = __builtin_amdgcn_mfma_f32_16x16x32_bf16(kt, vs, cacc[t5], 0, 0, 0); }
                    const f32x4 w_lo = *(const LAS f32x4*)(gb + 384 + 32 * ks + 8 * fq), w_hi = *(const LAS f32x4*)(gb + 384 + 32 * ks + 8 * fq + 4);
                    u32x4 ww; ww.x = cvt_pk(w_lo[0], w_lo[1]); ww.y = cvt_pk(w_lo[2], w_lo[3]); ww.z = cvt_pk(w_hi[0], w_hi[1]); ww.w = cvt_pk(w_hi[2], w_hi[3]);
                    if (fr != 0) ww = (u32x4){0u, 0u, 0u, 0u};
                    cacc[4] = __builtin_amdgcn_mfma_f32_16x16x32_bf16(kt, __builtin_bit_cast(bf16x8, ww), cacc[4], 0, 0, 0);
                }
            }
            __syncthreads();
            if (has_next) {
#pragma unroll
                for (int t5 = 0; t5 < 5; ++t5) { u32x2 o; o.x = cvt_pk(cacc[t5][0], cacc[t5][1]); o.y = cvt_pk(cacc[t5][2], cacc[t5][3]);
                    *(LAS u32x2*)(lds + L_CT + off_b(16 * t5 + fr, 2 * wave + (fq >> 1)) + (fq & 1) * 8) = o; }
                stage(ci + 1);
#pragma unroll
                for (int ks = 0; ks < 4; ++ks) qf[ks] = qn[ks];
            }
            __syncthreads();
        }
    }
}
}

#ifndef FAST_MLSTM
#define FAST_MLSTM 1
#endif

namespace pg8 {
typedef short bf16x8 __attribute__((ext_vector_type(8)));
constexpr int BM = 256, BK = 64, HALF = 128, HTB = HALF * BK * 2, STAGE_BYTES = 8 * HTB, NXCD = 8, WGM = 8;
__host__ __device__ __forceinline__ int lds_byte(int r, int c) { const int st = (r >> 4) * 2 + (c >> 5), rr = r & 15, cc = c & 31, ob = rr * 64 + cc * 2; return st * 1024 + (ob ^ (((ob >> 9) & 1) << 5)); }
__host__ __device__ __forceinline__ void stage_rc(int b, int& R, int& C) { const int st = b / 1024, sb = b % 1024, swz = sb ^ (((sb >> 9) & 1) << 5); R = (st >> 1) * 16 + swz / 64; C = (st & 1) * 32 + (swz % 64) / 2; }
__host__ __device__ __forceinline__ int perm32(int rho) { const int n = rho >> 4, i = rho & 15; return 8 * (i >> 2) + 4 * n + (i & 3); }
struct Unit { int pm, pn; };
struct Gemm { const bf16* A; const bf16* Bt; int lda, ldb, K, mode;
    __device__ __forceinline__ size_t a_off(const Unit& u) const { return mode == 0 ? (size_t)u.pm * 256 * lda : (size_t)(u.pm & 15) * 256 * lda; }
    __device__ __forceinline__ size_t b_off(const Unit& u) const { return mode == 0 ? (size_t)u.pn * 256 * ldb : (size_t)((u.pm >> 4) * 1024 + u.pn * 256) * ldb; }
};
struct StaticOrder {
    int nM, nN, nwg, G, c;
    __device__ __forceinline__ void init(int nM_, int nN_, int G_, int c_) { nM = nM_; nN = nN_; nwg = nM * nN; G = G_; c = c_; }
    __device__ __forceinline__ bool next(int i, Unit& u) const {
        const long L = (long)i * G + c; if (L >= nwg) return false;
        int wgid = (int)L; { const int q = nwg / NXCD, r = nwg % NXCD, xcd = wgid % NXCD, off = wgid / NXCD; wgid = (xcd < r ? xcd * (q + 1) : r * (q + 1) + (xcd - r) * q) + off; }
        const int nig = WGM * nN, gid = wgid / nig, fm = gid * WGM, gsz = (nM - fm) < WGM ? (nM - fm) : WGM;
        u.pm = fm + ((wgid % nig) % gsz); u.pn = (wgid % nig) / gsz; return true;
    }
};
__device__ __forceinline__ unsigned cvt_pk_bf16(float lo, float hi) { unsigned r; asm volatile("v_cvt_pk_bf16_f32 %0, %1, %2" : "=v"(r) : "v"(lo), "v"(hi)); return r; }
__device__ __forceinline__ u32x4 pack8(const f32x4 v0, const f32x4 v1) { u32x4 w; w.x = cvt_pk_bf16(v0[0], v0[1]); w.y = cvt_pk_bf16(v0[2], v0[3]); w.z = cvt_pk_bf16(v1[0], v1[1]); w.w = cvt_pk_bf16(v1[2], v1[3]); return w; }

struct EpiF32 {
    static constexpr bool PERM = false;
    float* C; int ldc; const float* bias;
    __device__ __forceinline__ void operator()(const f32x4 (&acc)[2][2][4][2], const Unit& u, int wr, int wc, int fr, int fq) const {
        const int row0 = u.pm * BM + wr * 64 + fr, col0 = u.pn * BM + wc * 32 + 4 * fq;
        f32x4 bv[2][2];
#pragma unroll
        for (int bj = 0; bj < 2; ++bj)
#pragma unroll
            for (int n = 0; n < 2; ++n) bv[bj][n] = bias ? *(const f32x4*)(bias + col0 + bj * HALF + n * 16) : (f32x4){0.f, 0.f, 0.f, 0.f};
#pragma unroll
        for (int ai = 0; ai < 2; ++ai)
#pragma unroll
            for (int m = 0; m < 4; ++m) { float* rowp = C + (size_t)(row0 + ai * HALF + m * 16) * ldc + col0;
#pragma unroll
                for (int bj = 0; bj < 2; ++bj)
#pragma unroll
                    for (int n = 0; n < 2; ++n) *(f32x4*)(rowp + bj * HALF + n * 16) = acc[ai][bj][m][n] + bv[bj][n]; }
    }
};
struct EpiInProj {
    static constexpr bool PERM = true;
    bf16 *Q, *Kb, *V, *O; float* Gt; const float* bias;
    __device__ __forceinline__ void operator()(const f32x4 (&acc)[2][2][4][2], const Unit& u, int wr, int wc, int fr, int fq) const {
        const int pn = u.pn, pm = u.pm, row0 = pm * BM + wr * 64 + fr;
        if (pn == 12) {
            if (wc == 0 && fq < 2) {
                const f32x4 b0 = *(const f32x4*)(bias + 3072 + 8 * fq), b1 = *(const f32x4*)(bias + 3072 + 8 * fq + 4);
#pragma unroll
                for (int ai = 0; ai < 2; ++ai)
#pragma unroll
                    for (int m = 0; m < 4; ++m) { float* p = Gt + (size_t)(row0 + ai * HALF + m * 16) * 16 + 8 * fq;
                        *(f32x4*)p = acc[ai][0][m][0] + b0; *(f32x4*)(p + 4) = acc[ai][0][m][1] + b1; }
            }
            return;
        }
        if (pm >= 64 && (pn < 2 || pn >= 8)) return;
        bf16* base; int ldc, colt; float sc = 1.f;
        if (pn < 2) { base = Q; ldc = 512; colt = pn * 256; }
        else if (pn < 4) { base = Kb; ldc = 512; colt = (pn - 2) * 256; sc = 0.08838834764831845f; }
        else if (pn < 8) { base = V; ldc = 1024; colt = (pn - 4) * 256; }
        else { base = O; ldc = 1024; colt = (pn - 8) * 256; }
        const int col0 = colt + wc * 32 + 8 * fq, bcol0 = pn * BM + wc * 32 + 8 * fq;
        f32x4 bv[2][2];
#pragma unroll
        for (int bj = 0; bj < 2; ++bj)
#pragma unroll
            for (int n = 0; n < 2; ++n) bv[bj][n] = *(const f32x4*)(bias + bcol0 + bj * HALF + 4 * n);
#pragma unroll
        for (int ai = 0; ai < 2; ++ai)
#pragma unroll
            for (int m = 0; m < 4; ++m) { bf16* rowp = base + (size_t)(row0 + ai * HALF + m * 16) * ldc + col0;
#pragma unroll
                for (int bj = 0; bj < 2; ++bj) { const f32x4 v0 = (acc[ai][bj][m][0] + bv[bj][0]) * sc, v1 = (acc[ai][bj][m][1] + bv[bj][1]) * sc;
                    *(u32x4*)(rowp + bj * HALF) = pack8(v0, v1); } }
    }
};
struct EpiSeqMix {
    static constexpr bool PERM = true;
    bf16* PQ;
    __device__ __forceinline__ void operator()(const f32x4 (&acc)[2][2][4][2], const Unit& u, int wr, int wc, int fr, int fq) const {
        const int b = u.pm >> 4, rt = u.pm & 15;
        const int row0 = b * 2048 + (rt & 7) * 256 + wr * 64 + fr, col0 = (rt >> 3) * 1024 + u.pn * 256 + wc * 32 + 8 * fq;
#pragma unroll
        for (int ai = 0; ai < 2; ++ai)
#pragma unroll
            for (int m = 0; m < 4; ++m) { bf16* rowp = PQ + (size_t)(row0 + ai * HALF + m * 16) * 2048 + col0;
#pragma unroll
                for (int bj = 0; bj < 2; ++bj) *(u32x4*)(rowp + bj * HALF) = pack8(acc[ai][bj][m][0], acc[ai][bj][m][1]); }
    }
};
__device__ __forceinline__ float dpp_ror1(float v) { return __int_as_float(__builtin_amdgcn_update_dpp(0, __float_as_int(v), 0x121, 0xf, 0xf, false)); }
__device__ __forceinline__ float dpp_rol1(float v) { return __int_as_float(__builtin_amdgcn_update_dpp(0, __float_as_int(v), 0x12f, 0xf, 0xf, false)); }
struct EpiUpConv {
    static constexpr bool PERM = true;
    bf16* ACT; const float* cw; const float* cb;
    __device__ __forceinline__ void operator()(const f32x4 (&acc)[2][2][4][2], const Unit& u, int wr, int wc, int fr, int fq) const {
        const int f0 = u.pn * 128 + wc * 32 + 8 * fq, row0 = u.pm * BM + wr * 64 + fr;
        f32x4 w0[2], w1[2], w2[2], bb[2];
#pragma unroll
        for (int n = 0; n < 2; ++n) { w0[n] = *(const f32x4*)(cw + f0 + 4 * n); w1[n] = *(const f32x4*)(cw + FF + f0 + 4 * n); w2[n] = *(const f32x4*)(cw + 2 * FF + f0 + 4 * n); bb[n] = *(const f32x4*)(cb + f0 + 4 * n); }
        const bool first = (fr == 0), last = (fr == 15);
#pragma unroll
        for (int ai = 0; ai < 2; ++ai) {
            f32x4 res[4][2];
#pragma unroll
            for (int n = 0; n < 2; ++n) {
                f32x4 R[4], L[4];
#pragma unroll
                for (int m = 0; m < 4; ++m)
#pragma unroll
                    for (int e = 0; e < 4; ++e) { R[m][e] = dpp_ror1(acc[ai][1][m][n][e]); L[m][e] = dpp_rol1(acc[ai][1][m][n][e]); }
#pragma unroll
                for (int m = 0; m < 4; ++m)
#pragma unroll
                    for (int e = 0; e < 4; ++e) {
                        const float pv = first ? (m > 0 ? R[m > 0 ? m - 1 : 0][e] : 0.f) : R[m][e];
                        const float nv = last ? (m < 3 ? L[m < 3 ? m + 1 : 3][e] : 0.f) : L[m][e];
                        const float gc = pv * w0[n][e] + acc[ai][1][m][n][e] * w1[n][e] + nv * w2[n][e] + bb[n][e];
                        res[m][n][e] = gc * __builtin_amdgcn_rcpf(1.f + __expf(-gc)) * acc[ai][0][m][n][e];
                    }
            }
#pragma unroll
            for (int m = 0; m < 4; ++m) *(u32x4*)(ACT + (size_t)(row0 + ai * HALF + m * 16) * FF + f0) = pack8(res[m][0], res[m][1]);
        }
    }
};

template <class Epi, bool ALIGN_EPI = true>
__device__ __forceinline__ void gemm_phase(LAS unsigned char* lds, const Gemm g, const StaticOrder& S, const Epi& E) {
    const int tid = threadIdx.x, wid = __builtin_amdgcn_readfirstlane(tid >> 6), lane = tid & 63, wr = wid >> 2, wc = wid & 3, fr = lane & 15, fq = lane >> 4;
    const int K = g.K, nt = K / BK;
    unsigned voffA[2], voffB[2];
#pragma unroll
    for (int i = 0; i < 2; ++i) { int R, C; stage_rc(tid * 16 + i * 8192, R, C); const int Rb = Epi::PERM ? ((R & ~31) + perm32(R & 31)) : R;
        voffA[i] = (unsigned)(R * g.lda + C) * 2u; voffB[i] = (unsigned)(Rb * g.ldb + C) * 2u; }
    const size_t kstep = (size_t)(BK * 2);
    const size_t hstepA = (size_t)HALF * g.lda * 2, hstepB = (size_t)HALF * g.ldb * 2;
    const unsigned ldsw = (unsigned)wid * 1024u;
    const int aoff = lds_byte(wr * 64 + fr, fq * 8), boff = lds_byte(wc * 32 + fr, fq * 8);
#define PG8_SA(b, h) (((b) * 2 + (h)) * HTB)
#define PG8_SB(b, h) ((4 + (b) * 2 + (h)) * HTB)
#define PG8_STAGE(bufoff, gbase, voff) do { _Pragma("unroll") for (int _i = 0; _i < 2; ++_i) \
        __builtin_amdgcn_global_load_lds((const unsigned*)((const char*)(gbase) + (voff)[_i]), (LAS unsigned*)(lds + (bufoff) + ldsw + _i * 8192), 16, 0, 0); } while (0)
#define PG8_LDA(dst, b, h) do { _Pragma("unroll") for (int m = 0; m < 4; ++m) _Pragma("unroll") for (int k = 0; k < 2; ++k) dst[m][k] = *(const LAS bf16x8*)(lds + PG8_SA(b, h) + aoff + m * 2048 + k * 1024); } while (0)
#define PG8_LDB(dst, b, h) do { _Pragma("unroll") for (int n = 0; n < 2; ++n) _Pragma("unroll") for (int k = 0; k < 2; ++k) dst[n][k] = *(const LAS bf16x8*)(lds + PG8_SB(b, h) + boff + n * 2048 + k * 1024); } while (0)
#define PG8_MMA(ai, bj, At, Bt) do { __builtin_amdgcn_s_setprio(1); _Pragma("unroll") for (int m = 0; m < 4; ++m) _Pragma("unroll") for (int n = 0; n < 2; ++n) _Pragma("unroll") for (int k = 0; k < 2; ++k) \
        acc[ai][bj][m][n] = __builtin_amdgcn_mfma_f32_16x16x32_bf16(Bt[n][k], At[m][k], acc[ai][bj][m][n], 0, 0, 0); __builtin_amdgcn_s_setprio(0); } while (0)
#define PG8_WAIT_V(n) asm volatile("s_waitcnt vmcnt(" #n ")" ::: "memory")
#define PG8_WAIT_L(n) asm volatile("s_waitcnt lgkmcnt(" #n ")" ::: "memory")
#define PG8_BAR __builtin_amdgcn_s_barrier()
#define PG8_SCHED __builtin_amdgcn_sched_barrier(0)
    Unit cur, nxt; int ui = 0;
    if (!S.next(0, cur)) return;
    f32x4 acc[2][2][4][2];
#pragma unroll
    for (int a = 0; a < 2; ++a)
#pragma unroll
        for (int b = 0; b < 2; ++b)
#pragma unroll
            for (int m = 0; m < 4; ++m)
#pragma unroll
                for (int n = 0; n < 2; ++n) acc[a][b][m][n] = (f32x4){0.f, 0.f, 0.f, 0.f};
    bf16x8 At[4][2], B0[2][2], B1[2][2];
    const char* cA = (const char*)g.A + g.a_off(cur) * 2; const char* cB = (const char*)g.Bt + g.b_off(cur) * 2;
    PG8_STAGE(PG8_SB(0, 0), cB, voffB); PG8_STAGE(PG8_SB(0, 1), cB + hstepB, voffB); PG8_STAGE(PG8_SA(0, 0), cA, voffA); PG8_STAGE(PG8_SA(0, 1), cA + hstepA, voffA);
    if (wr == 1) PG8_BAR;
    PG8_WAIT_V(2); PG8_BAR;
    PG8_STAGE(PG8_SB(1, 0), cB + kstep, voffB); PG8_STAGE(PG8_SA(1, 0), cA + kstep, voffA); PG8_STAGE(PG8_SB(1, 1), cB + hstepB + kstep, voffB);
    PG8_WAIT_V(6); PG8_BAR;
    for (;;) {
        const bool has_next = S.next(ui + 1, nxt);
        const char* nA = has_next ? (const char*)g.A + g.a_off(nxt) * 2 : cA; const char* nB = has_next ? (const char*)g.Bt + g.b_off(nxt) * 2 : cB;
        for (int t = 0; t < nt; t += 2) {
            const bool last = (t == nt - 2);
            const char* a1 = cA + (size_t)(t + 1) * kstep;
            const char* a2 = last ? nA : cA + (size_t)(t + 2) * kstep; const char* b2 = last ? nB : cB + (size_t)(t + 2) * kstep;
            const char* a3 = a2 + kstep; const char* b3 = b2 + kstep;
            PG8_LDB(B0, 0, 0); PG8_LDB(B1, 0, 1); PG8_SCHED; PG8_LDA(At, 0, 0); PG8_STAGE(PG8_SA(1, 1), a1 + hstepA, voffA);
            PG8_WAIT_V(8); PG8_WAIT_L(0); PG8_BAR; PG8_MMA(0, 0, At, B0); PG8_MMA(0, 1, At, B1); PG8_BAR; PG8_SCHED;
            PG8_LDA(At, 0, 1); PG8_STAGE(PG8_SB(0, 0), b2, voffB); PG8_STAGE(PG8_SB(0, 1), b2 + hstepB, voffB); PG8_STAGE(PG8_SA(0, 0), a2, voffA);
            PG8_WAIT_V(8); PG8_WAIT_L(0); PG8_BAR; PG8_MMA(1, 0, At, B0); PG8_MMA(1, 1, At, B1); PG8_BAR; PG8_SCHED;
            PG8_LDB(B0, 1, 0); PG8_LDB(B1, 1, 1); PG8_SCHED; PG8_LDA(At, 1, 0); PG8_STAGE(PG8_SA(0, 1), a2 + hstepA, voffA);
            PG8_WAIT_V(8); PG8_WAIT_L(0); PG8_BAR; PG8_MMA(0, 0, At, B0); PG8_MMA(0, 1, At, B1); PG8_BAR; PG8_SCHED;
            PG8_LDA(At, 1, 1); PG8_STAGE(PG8_SB(1, 0), b3, voffB); PG8_STAGE(PG8_SB(1, 1), b3 + hstepB, voffB); PG8_STAGE(PG8_SA(1, 0), a3, voffA);
            PG8_WAIT_V(8); PG8_WAIT_L(0); PG8_BAR; PG8_MMA(1, 0, At, B0); PG8_MMA(1, 1, At, B1); PG8_BAR; PG8_SCHED;
        }
        if constexpr (ALIGN_EPI) { if (wr == 0) PG8_BAR; }
        E(acc, cur, wr, wc, fr, fq);
        if (!has_next) break;
#pragma unroll
        for (int a = 0; a < 2; ++a)
#pragma unroll
            for (int b = 0; b < 2; ++b)
#pragma unroll
                for (int m = 0; m < 4; ++m)
#pragma unroll
                    for (int n = 0; n < 2; ++n) acc[a][b][m][n] = (f32x4){0.f, 0.f, 0.f, 0.f};
        cur = nxt; cA = nA; cB = nB; ++ui;
        if constexpr (ALIGN_EPI) { if (wr == 1) PG8_BAR; }
    }
    PG8_WAIT_V(0);
    if constexpr (!ALIGN_EPI) { if (wr == 0) PG8_BAR; }
    PG8_BAR;
#undef PG8_SA
#undef PG8_SB
#undef PG8_STAGE
#undef PG8_LDA
#undef PG8_LDB
#undef PG8_MMA
#undef PG8_WAIT_V
#undef PG8_WAIT_L
#undef PG8_BAR
#undef PG8_SCHED
}
}

#ifndef FAST_GEMM
#define FAST_GEMM 1
#endif


#define XB_TMO      128
#define XB_XCNT(j)  (256  + 64 * (j))
#define XB_XSUB(j)  (1280 + 64 * (j))
#define XB_XGEN(j)  (2304 + 64 * (j))
#define XB_TOP      3328
#define XB_TOPGEN   3392
#define XCD_BAR_WORDS 3456
#define XB_SPIN_CAP (1u << 20)
__device__ __forceinline__ unsigned xb_ld(unsigned* p)              { return __hip_atomic_load(p, __ATOMIC_RELAXED, __HIP_MEMORY_SCOPE_AGENT); }
__device__ __forceinline__ unsigned xb_add(unsigned* p, unsigned v) { return __hip_atomic_fetch_add(p, v, __ATOMIC_RELAXED, __HIP_MEMORY_SCOPE_AGENT); }
__device__ __forceinline__ unsigned xb_xcc_id() { return (unsigned)__builtin_amdgcn_s_getreg((3 << 11) | 20) & 0xFu; }
#define XB_SPIN(cond, bar) do { unsigned _sp = 0; while (cond) { __builtin_amdgcn_s_sleep(1); \
    if ((++_sp & 255u) == 0u) { if (xb_ld(&(bar)[XB_TMO])) break; if (_sp > XB_SPIN_CAP) { atomicAdd(&(bar)[XB_TMO], 1u); break; } } } } while (0)
struct XcdBarrier { unsigned* bar; unsigned x; volatile LAS unsigned* st; };
__device__ __forceinline__ XcdBarrier xcd_barrier_post(unsigned* bar, volatile LAS unsigned* st) {
    XcdBarrier b; b.bar = bar; b.x = xb_xcc_id(); b.st = st;
    if (threadIdx.x == 0) (void)xb_add(&bar[XB_XCNT(b.x)], 1u);
    return b;
}
__device__ __forceinline__ void xcd_barrier_complete(unsigned* bar, unsigned x, unsigned& nloc, unsigned& nx) {
    const unsigned G = gridDim.x * gridDim.y * gridDim.z;
    unsigned sum, cnt, mine, sp = 0u;
    for (;;) {
        sum = 0u; cnt = 0u; mine = 0u;
#pragma unroll
        for (unsigned j = 0; j < 16; ++j) { const unsigned c = xb_ld(&bar[XB_XCNT(j)]); sum += c; cnt += (c > 0u) ? 1u : 0u; mine = (j == x) ? c : mine; }
        if (sum == G) break;
        __builtin_amdgcn_s_sleep(1);
        if ((++sp & 255u) == 0u) { if (xb_ld(&bar[XB_TMO])) break; if (sp > XB_SPIN_CAP) { atomicAdd(&bar[XB_TMO], 1u); break; } }
    }
    nloc = mine > 0u ? mine : 1u; nx = cnt > 0u ? cnt : 1u;
}
__device__ __forceinline__ void xcd_barrier(const XcdBarrier& b) {
    asm volatile("s_waitcnt vmcnt(0)" ::: "memory");
    __syncthreads();
    if (threadIdx.x == 0) {
        unsigned* bar = b.bar;
        __builtin_amdgcn_s_waitcnt(0);
        unsigned nloc = b.st[0], nx = b.st[1];
        if (nloc == 0u) { xcd_barrier_complete(bar, b.x, nloc, nx); b.st[0] = nloc; b.st[1] = nx; }
        const unsigned old = xb_add(&bar[XB_XSUB(b.x)], 1u);
        const unsigned gen = old / nloc;
        if (old + 1u == (gen + 1u) * nloc) {
            __builtin_amdgcn_fence(__ATOMIC_RELEASE, "agent");
            asm volatile("s_waitcnt vmcnt(0)" ::: "memory");
            const unsigned og = xb_add(&bar[XB_TOP], 1u);
            const unsigned tg = og / nx;
            if (og + 1u == (tg + 1u) * nx) xb_add(&bar[XB_TOPGEN], 1u);
            else XB_SPIN(xb_ld(&bar[XB_TOPGEN]) == tg, bar);
            __builtin_amdgcn_fence(__ATOMIC_ACQUIRE, "agent");
            xb_add(&bar[XB_XGEN(b.x)], 1u);
            asm volatile("s_waitcnt vmcnt(0)" ::: "memory");
        } else {
            XB_SPIN(xb_ld(&bar[XB_XGEN(b.x)]) == gen, bar);
            __builtin_amdgcn_fence(__ATOMIC_ACQUIRE, "agent");
            asm volatile("s_waitcnt vmcnt(0)" ::: "memory");
        }
    }
    __syncthreads();
}

__global__ void __launch_bounds__(NTHR, 2) mk_fwd(Args a) {
    extern __shared__ __attribute__((aligned(16))) unsigned char lds_raw[];
    LAS unsigned char* lds = (LAS unsigned char*)lds_raw;
    const int tid = threadIdx.x, lane = tid & 63, wave = __builtin_amdgcn_readfirstlane(tid >> 6), G = gridDim.x;
    const int lo = a.ph_lo, hi = a.ph_hi;
    unsigned char* ws = a.ws;
    const float* MOD0 = (const float*)(ws + WS_MOD); const float* MOD1 = MOD0 + 9 * 6144;
#define IN(k) (lo <= (k) && (k) < hi)
#define SEAM(k) do { if (IN(k) && IN((k) + 1)) { if ((k) == 0) { __threadfence(); cg::this_grid().sync(); } else xcd_barrier(xbar); } } while (0)
    {
        volatile LAS unsigned* st = (volatile LAS unsigned*)(lds + LDS_BYTES - 64);
        if (tid < 16) st[tid] = 0u;
        __syncthreads();
    }
    XcdBarrier xbar = xcd_barrier_post((unsigned*)(ws + WS_CTL) + 4096, (volatile LAS unsigned*)(lds + LDS_BYTES - 64));

    if (IN(0)) { p0_prep(a, lds, tid, lane, wave, G); } SEAM(0);
    if (IN(1)) { p1_norm_mod(a, lane, wave, G); } SEAM(1);
#if FAST_GEMM
    if (IN(2)) { pg8::Gemm g{(const bf16*)(ws + WS_A), (const bf16*)(ws + WS_WIN), D, D, D, 0}; pg8::StaticOrder S; S.init(MALL / 256, NPROJ_PAD / 256, G, (int)blockIdx.x);
        pg8::EpiInProj E{(bf16*)(ws + WS_Q), (bf16*)(ws + WS_K), (bf16*)(ws + WS_V), (bf16*)(ws + WS_O), (float*)(ws + WS_G), a.in[15]};
        pg8::gemm_phase<pg8::EpiInProj>(lds, g, S, E); } SEAM(2);
#else
    if (IN(2)) { p2_inproj_simple(a, lds, tid, G); } SEAM(2);
#endif
#if FAST_MLSTM
    if (IN(3)) { ml::mlstm_phase(a, lds, tid, lane, wave, G); } SEAM(3);
#else
    if (IN(3)) { p3_mlstm_simple(a, lds, tid, G); } SEAM(3);
#endif
    if (IN(4)) { p4_readout(a, lane, wave, G); } SEAM(4);
#if FAST_GEMM
    if (IN(5)) { pg8::Gemm g{(const bf16*)(ws + WS_Y), (const bf16*)(ws + WS_WOUT), D, D, D, 0}; pg8::StaticOrder S; S.init(ML / 256, D / 256, G, (int)blockIdx.x);
        pg8::EpiF32 E{(float*)(ws + WS_Y1), D, nullptr}; pg8::gemm_phase<pg8::EpiF32>(lds, g, S, E); } SEAM(5);
#else
    if (IN(5)) { gemm_simple_f32((const bf16*)(ws + WS_Y), D, (const bf16*)(ws + WS_WOUT), D, ML, D, D, (float*)(ws + WS_Y1), D, nullptr, lds, tid, G); } SEAM(5);
#endif
    if (IN(6)) { rowpass<1>((const float*)(ws + WS_Y1), a.in[0], a.out, MOD0 + 2 * D, a.in[7], a.in[8], MOD0 + 3 * D, MOD0 + 4 * D, (bf16*)(ws + WS_H2), lane, wave, G); } SEAM(6);
#if FAST_GEMM
    if (IN(7)) { pg8::Gemm g{(const bf16*)(ws + WS_H2), (const bf16*)(ws + WS_WUP), D, D, D, 0}; pg8::StaticOrder S; S.init(ML / 256, NUP / 256, G, (int)blockIdx.x);
        pg8::EpiUpConv E{(bf16*)(ws + WS_ACT), a.in[11], a.in[12]}; pg8::gemm_phase<pg8::EpiUpConv>(lds, g, S, E); } SEAM(7);
    if (IN(8)) { pg8::Gemm g{(const bf16*)(ws + WS_ACT), (const bf16*)(ws + WS_WDN), FF, FF, FF, 0}; pg8::StaticOrder S; S.init(ML / 256, D / 256, G, (int)blockIdx.x);
        pg8::EpiF32 E{(float*)(ws + WS_Y2), D, nullptr}; pg8::gemm_phase<pg8::EpiF32>(lds, g, S, E); } SEAM(8);
#else
    if (IN(7)) { p7_up_simple((const bf16*)(ws + WS_H2), (const bf16*)(ws + WS_WUP), a.in[11], a.in[12], (bf16*)(ws + WS_ACT), lds, tid, G); } SEAM(7);
    if (IN(8)) { gemm_simple_f32((const bf16*)(ws + WS_ACT), FF, (const bf16*)(ws + WS_WDN), FF, ML, D, FF, (float*)(ws + WS_Y2), D, nullptr, lds, tid, G); } SEAM(8);
#endif
    if (IN(9)) { rowpass_t((const float*)(ws + WS_Y2), a.out, a.out, MOD0 + 5 * D, a.in[9], a.in[6] + D, MOD1, MOD1 + D, (bf16*)(ws + WS_HT), lds, tid, lane, wave, G); } SEAM(9);
#if FAST_GEMM
    if (IN(10)) { pg8::Gemm g{(const bf16*)(ws + WS_DFT), (const bf16*)(ws + WS_HT), 2048, 2048, 2048, 1}; pg8::StaticOrder S; S.init(NB * 16, 4, G, (int)blockIdx.x);
        pg8::EpiSeqMix E{(bf16*)(ws + WS_PQ)}; pg8::gemm_phase<pg8::EpiSeqMix>(lds, g, S, E); } SEAM(10);
    if (IN(11)) { pg8::Gemm g{(const bf16*)(ws + WS_PQ), (const bf16*)(ws + WS_WCS), 2048, 2048, 2048, 0}; pg8::StaticOrder S; S.init(ML / 256, D / 256, G, (int)blockIdx.x);
        pg8::EpiF32 E{(float*)(ws + WS_Y3), D, a.in[19]}; pg8::gemm_phase<pg8::EpiF32>(lds, g, S, E); } SEAM(11);
#else
    if (IN(10)) { p10_seqmix_simple(a, lds, tid, G); } SEAM(10);
    if (IN(11)) { gemm_simple_f32((const bf16*)(ws + WS_PQ), 2048, (const bf16*)(ws + WS_WCS), 2048, ML, D, 2048, (float*)(ws + WS_Y3), D, a.in[19], lds, tid, G); } SEAM(11);
#endif
    if (IN(12)) { rowpass<1>((const float*)(ws + WS_Y3), a.out, a.out, MOD1 + 2 * D, a.in[7] + D, a.in[8] + D, MOD1 + 3 * D, MOD1 + 4 * D, (bf16*)(ws + WS_H2B), lane, wave, G); } SEAM(12);
#if FAST_GEMM
    if (IN(13)) { pg8::Gemm g{(const bf16*)(ws + WS_H2B), (const bf16*)(ws + WS_WUP) + (size_t)NUP * D, D, D, D, 0}; pg8::StaticOrder S; S.init(ML / 256, NUP / 256, G, (int)blockIdx.x);
        pg8::EpiUpConv E{(bf16*)(ws + WS_ACT1), a.in[11] + 3 * FF, a.in[12] + FF}; pg8::gemm_phase<pg8::EpiUpConv>(lds, g, S, E); } SEAM(13);
    if (IN(14)) { pg8::Gemm g{(const bf16*)(ws + WS_ACT1), (const bf16*)(ws + WS_WDN) + (size_t)D * FF, FF, FF, FF, 0}; pg8::StaticOrder S; S.init(ML / 256, D / 256, G, (int)blockIdx.x);
        pg8::EpiF32 E{(float*)(ws + WS_Y2B), D, nullptr}; pg8::gemm_phase<pg8::EpiF32>(lds, g, S, E); } SEAM(14);
#else
    if (IN(13)) { p7_up_simple((const bf16*)(ws + WS_H2B), (const bf16*)(ws + WS_WUP) + (size_t)NUP * D, a.in[11] + 3 * FF, a.in[12] + FF, (bf16*)(ws + WS_ACT1), lds, tid, G); } SEAM(13);
    if (IN(14)) { gemm_simple_f32((const bf16*)(ws + WS_ACT1), FF, (const bf16*)(ws + WS_WDN) + (size_t)D * FF, FF, ML, D, FF, (float*)(ws + WS_Y2B), D, nullptr, lds, tid, G); } SEAM(14);
#endif
    if (IN(15)) { rowpass<0>((const float*)(ws + WS_Y2B), a.out, a.out, MOD1 + 5 * D, a.in[9] + D, nullptr, nullptr, nullptr, nullptr, lane, wave, G); }
#undef IN
#undef SEAM
}

extern "C" void kernel_launch(void* const* d_in, const int* in_sizes, int n_in, void* d_out, int out_size, void* d_ws, size_t ws_size, hipStream_t stream) {
    static int grid = 0;
    if (grid == 0) {
        if (n_in != 20 || out_size != ML * D || ws_size < WS_END) { fprintf(stderr, "kernel_launch: unexpected shapes (n_in %d out %d ws %zu)\n", n_in, out_size, ws_size); grid = -1; return; }
        int dev = 0, cus = 0, per_cu = 0;
        (void)hipGetDevice(&dev); (void)hipDeviceGetAttribute(&cus, hipDeviceAttributeMultiprocessorCount, dev);
        (void)hipFuncSetAttribute((const void*)mk_fwd, hipFuncAttributeMaxDynamicSharedMemorySize, LDS_BYTES);
        (void)hipOccupancyMaxActiveBlocksPerMultiprocessor(&per_cu, (const void*)mk_fwd, NTHR, LDS_BYTES);
        if (per_cu < 1) { fprintf(stderr, "kernel_launch: occupancy query says %d blocks/CU\n", per_cu); per_cu = 1; }
        grid = cus * 1;
        (void)hipGetLastError();
    }
    if (grid < 0) return;
    (void)hipMemsetAsync((char*)d_ws + WS_CTL, 0, 1 * MiB, stream);
    Args a{};
    for (int i = 0; i < 20; ++i) a.in[i] = (const float*)d_in[i];
    a.out = (float*)d_out; a.ws = (unsigned char*)d_ws;
    if (MK_N_LAUNCHES == 1) {
        a.ph_lo = 0; a.ph_hi = NPH;
        void* args[] = {&a};
        hipError_t e = hipLaunchCooperativeKernel((const void*)mk_fwd, dim3(grid), dim3(NTHR), args, LDS_BYTES, stream);
        if (e != hipSuccess) fprintf(stderr, "cooperative launch failed: %s (grid %d)\n", hipGetErrorString(e), grid);
    } else {
        for (int p = 0; p < NPH; ++p) { a.ph_lo = p; a.ph_hi = p + 1;
            hipLaunchKernelGGL(mk_fwd, dim3(grid), dim3(NTHR), LDS_BYTES, stream, a); }
    }
}
```

```cpp
#include <hip/hip_runtime.h>
#include <hip/hip_cooperative_groups.h>
#include <cstdio>
#include <cstdint>
namespace cg = cooperative_groups;

#ifndef MK_N_LAUNCHES
#define MK_N_LAUNCHES 1
#endif

#define GAS __attribute__((address_space(1)))
#define LAS __attribute__((address_space(3)))
typedef unsigned short bf16;
typedef float f32x4 __attribute__((ext_vector_type(4)));
typedef unsigned u32x4 __attribute__((ext_vector_type(4)));
typedef unsigned u32x2 __attribute__((ext_vector_type(2)));

constexpr int D = 1024, NB = 8, T = 2048, TC = 256;
constexpr int ML = NB * T;
constexpr int MC = NB * TC;
constexpr int MALL = ML + MC;
constexpr int NH = 4, DK = 128, DV = 256;
constexpr int NPROJ = 3088, NPROJ_PAD = 3328;
constexpr int FF = 2816, NUP = 2 * FF;
constexpr float EPS = 1e-6f;
constexpr int NPH = 16;
constexpr int NWAVES = 8, NTHR = 512;

constexpr size_t MiB = 1u << 20;
constexpr size_t WS_CTL = 0;
constexpr size_t WS_MOD = 1 * MiB;
constexpr size_t WS_WIN = 2 * MiB;
constexpr size_t WS_WOUT = WS_WIN + (size_t)NPROJ_PAD * D * 2;
constexpr size_t WS_WUP = WS_WOUT + (size_t)D * D * 2;
constexpr size_t WS_WDN = WS_WUP + (size_t)2 * NUP * D * 2;
constexpr size_t WS_WCS = WS_WDN + (size_t)2 * D * FF * 2;
constexpr size_t WS_DFT = WS_WCS + (size_t)D * 2048 * 2;
constexpr size_t WS_A = WS_DFT + (size_t)4096 * 2048 * 2;
constexpr size_t WS_C = WS_A + (size_t)MALL * D * 2;
constexpr size_t WS_B = WS_C + (size_t)ML * D * 2;
constexpr size_t WS_Q = WS_B;
constexpr size_t WS_K = WS_Q + (size_t)ML * 512 * 2;
constexpr size_t WS_V = WS_K + (size_t)MALL * 512 * 2;
constexpr size_t WS_O = WS_V + (size_t)MALL * D * 2;
constexpr size_t WS_G = WS_O + (size_t)ML * D * 2;
constexpr size_t WS_END = WS_B + 104 * MiB;
static_assert(WS_G + (size_t)MALL * 16 * 4 <= WS_END, "region B");
static_assert(WS_END <= 256 * MiB, "workspace");
constexpr size_t WS_HF = WS_A;
constexpr size_t WS_HB = WS_C;
constexpr size_t WS_Y = WS_Q;
constexpr size_t WS_Y1 = WS_V;
constexpr size_t WS_H2 = WS_A;
constexpr size_t WS_ACT = WS_B;
constexpr size_t WS_Y2 = WS_A;
constexpr size_t WS_HT = WS_B;
constexpr size_t WS_PQ = WS_B + 32 * MiB;
constexpr size_t WS_Y3 = WS_A;
constexpr size_t WS_H2B = WS_B + 72 * MiB;
constexpr size_t WS_ACT1 = WS_A;
constexpr size_t WS_Y2B = WS_B + 24 * MiB;
static_assert(WS_V + (size_t)ML * D * 4 <= WS_G, "y1 overlay");
static_assert(WS_ACT1 + (size_t)ML * FF * 2 <= WS_H2B && WS_ACT1 + (size_t)ML * FF * 2 <= WS_Y2B, "layer-1 overlays");
static_assert(WS_Y2B + (size_t)ML * D * 4 <= WS_END && WS_H2B + (size_t)ML * D * 2 <= WS_END && WS_PQ + (size_t)ML * 2048 * 2 <= WS_END, "layer-1 overlays");

constexpr int LDS_BYTES = 147456;

__device__ __forceinline__ float bf2f(unsigned v) { return __uint_as_float(v << 16); }
__device__ __forceinline__ unsigned f2bf(float f) { unsigned u = __float_as_uint(f); return (u + 0x7fffu + ((u >> 16) & 1u)) >> 16; }
__device__ __forceinline__ unsigned pk2(float lo, float hi) { return f2bf(lo) | (f2bf(hi) << 16); }
__device__ __forceinline__ float silu_f(float v) { return v / (1.f + __expf(-v)); }
__device__ __forceinline__ float sigmoid_f(float v) { return 1.f / (1.f + __expf(-v)); }
__device__ __forceinline__ float logsigmoid_f(float v) { return fminf(v, 0.f) - log1pf(__expf(-fabsf(v))); }
__device__ __forceinline__ float wave_sum(float v) {
#pragma unroll
    for (int o = 1; o < 64; o <<= 1) v += __shfl_xor(v, o);
    return v;
}

namespace ml {
typedef short bf16x8 __attribute__((ext_vector_type(8)));
typedef short s16x4 __attribute__((ext_vector_type(4)));
__device__ __forceinline__ unsigned off_b(unsigned row, unsigned ch) { return 256u * row + 16u * (ch ^ (((row & 3) << 2) | ((row >> 2) & 3))); }
__device__ __forceinline__ unsigned off_v(unsigned row, unsigned c32) { return 128u * row + 32u * (c32 ^ (((row >> 1) & 1) | (((row >> 3) & 1) << 1))); }
__device__ __forceinline__ bf16x8 tr8_b(LAS unsigned char* img, int lane, int c, int ks) {
    const unsigned g = lane >> 4, q = (lane & 15) >> 2, p = lane & 3;
    const s16x4 lo = __builtin_amdgcn_ds_read_tr16_b64_v4i16((LAS s16x4*)(img + off_b(32 * ks + 8 * g + q, 2 * c + (p >> 1)) + 8 * (p & 1)));
    const s16x4 hi = __builtin_amdgcn_ds_read_tr16_b64_v4i16((LAS s16x4*)(img + off_b(32 * ks + 8 * g + 4 + q, 2 * c + (p >> 1)) + 8 * (p & 1)));
    return __builtin_shufflevector(lo, hi, 0, 1, 2, 3, 4, 5, 6, 7);
}
__device__ __forceinline__ bf16x8 tr8_v(LAS unsigned char* img, int lane, int c, int ks) {
    const unsigned g = lane >> 4, q = (lane & 15) >> 2, p = lane & 3;
    const s16x4 lo = __builtin_amdgcn_ds_read_tr16_b64_v4i16((LAS s16x4*)(img + off_v(32 * ks + 8 * g + q, c) + 8 * p));
    const s16x4 hi = __builtin_amdgcn_ds_read_tr16_b64_v4i16((LAS s16x4*)(img + off_v(32 * ks + 8 * g + 4 + q, c) + 8 * p));
    return __builtin_shufflevector(lo, hi, 0, 1, 2, 3, 4, 5, 6, 7);
}
__device__ __forceinline__ unsigned cvt_pk(float lo, float hi) { unsigned r; asm volatile("v_cvt_pk_bf16_f32 %0, %1, %2" : "=v"(r) : "v"(lo), "v"(hi)); return r; }

}

struct Args { const float* in[20]; float* out; unsigned char* ws; int ph_lo, ph_hi; };

template <int MODE>
__device__ __forceinline__ void p0_transpose_item(const float* W, int K, int N, bf16* WT, LAS float* scr, int item, int nblk, int lane) {
    const int kb = item / nblk, nb = item % nblk, k0 = 64 * kb, n0 = 32 * nb;
    float tv[32];
#pragma unroll
    for (int i = 0; i < 32; ++i) { const int kk = 2 * i + (lane >> 5); const int n = n0 + (lane & 31);
        tv[i] = (n < N) ? W[(size_t)(k0 + kk) * N + n] : 0.f; }
#pragma unroll
    for (int i = 0; i < 32; ++i) { const int kk = 2 * i + (lane >> 5); scr[kk * 33 + (lane & 31)] = tv[i]; }
    asm volatile("s_waitcnt lgkmcnt(0)" ::: "memory");
    const int c = lane & 7;
#pragma unroll
    for (int j = 0; j < 4; ++j) { const int nl = (lane >> 3) + 8 * j; const LAS float* s = scr + (8 * c) * 33 + nl;
        u32x4 o; o.x = pk2(s[0 * 33], s[1 * 33]); o.y = pk2(s[2 * 33], s[3 * 33]); o.z = pk2(s[4 * 33], s[5 * 33]); o.w = pk2(s[6 * 33], s[7 * 33]);
        int n = n0 + nl, dr = n;
        if (MODE == 1) { const int isg = n >= FF ? 1 : 0; const int jj = n - isg * FF; dr = (jj >> 7) * 256 + isg * 128 + (jj & 127); }
        *(u32x4*)(WT + (size_t)dr * K + k0 + 8 * c) = o; }
    asm volatile("s_waitcnt lgkmcnt(0)" ::: "memory");
}

__device__ __forceinline__ void p0_prep(const Args& a, LAS unsigned char* lds, int tid, int lane, int wave, int G) {
    unsigned char* ws = a.ws;
    {
        LAS float* scr = (LAS float*)(lds + wave * 16384);
        const int gw = blockIdx.x * NWAVES + wave, NGW = G * NWAVES;
        constexpr int I_IN = 16 * (NPROJ_PAD / 32), I_OUT = 16 * 32, I_UP = 16 * (NUP / 32), I_DN = (FF / 64) * 32;
        constexpr int NIT = I_IN + I_OUT + 2 * I_UP + 2 * I_DN;
        for (int it = gw; it < NIT; it += NGW) {
            int r = it;
            if (r < I_IN) { p0_transpose_item<0>(a.in[14], D, NPROJ, (bf16*)(ws + WS_WIN), scr, r, NPROJ_PAD / 32, lane); continue; } r -= I_IN;
            if (r < I_OUT) { p0_transpose_item<0>(a.in[17], D, D, (bf16*)(ws + WS_WOUT), scr, r, 32, lane); continue; } r -= I_OUT;
            if (r < I_UP) { p0_transpose_item<1>(a.in[10], D, NUP, (bf16*)(ws + WS_WUP), scr, r, NUP / 32, lane); continue; } r -= I_UP;
            if (r < I_UP) { p0_transpose_item<1>(a.in[10] + (size_t)D * NUP, D, NUP, (bf16*)(ws + WS_WUP) + (size_t)NUP * D, scr, r, NUP / 32, lane); continue; } r -= I_UP;
            if (r < I_DN) { p0_transpose_item<0>(a.in[13], FF, D, (bf16*)(ws + WS_WDN), scr, r, 32, lane); continue; } r -= I_DN;
            p0_transpose_item<0>(a.in[13] + (size_t)FF * D, FF, D, (bf16*)(ws + WS_WDN) + (size_t)D * FF, scr, r, 32, lane);
        }
    }
    __syncthreads();
    LAS float* tab = (LAS float*)(lds + 131072);
    for (int i = tid; i < 2048; i += NTHR) tab[i] = cospif((float)i * (1.0f / 1024.0f));
    __syncthreads();
    {
        bf16* DF = (bf16*)(ws + WS_DFT);
        const int total = 4096 * 256;
        for (int idx = blockIdx.x * NTHR + tid; idx < total; idx += G * NTHR) {
            const int r = idx >> 8, t0 = (idx & 255) * 8, tp = r & 2047, sh = (r >> 11) ? 512 : 0;
            float v[8];
#pragma unroll
            for (int j = 0; j < 8; ++j) v[j] = tab[(tp * (t0 + j) + sh) & 2047] * (1.0f / 512.0f);
            u32x4 o; o.x = pk2(v[0], v[1]); o.y = pk2(v[2], v[3]); o.z = pk2(v[4], v[5]); o.w = pk2(v[6], v[7]);
            *(u32x4*)(DF + (size_t)r * 2048 + t0) = o;
        }
    }
    {
        const float* W = a.in[18]; bf16* WCS = (bf16*)(ws + WS_WCS);
        LAS unsigned char* tc = lds;
        LAS unsigned char* tsn = lds + 32768;
        LAS unsigned char* wt = lds + 65536;
        const int fr = lane & 15, fq = lane >> 4;
        if ((int)blockIdx.x < 128) {
            for (int i = tid; i < 128 * 16; i += NTHR) { const int r = i >> 4, ch = i & 15; float cv[8], sv[8];
#pragma unroll
                for (int j = 0; j < 8; ++j) { const int ph = ((r * (ch * 8 + j)) & 127) * 16; cv[j] = tab[ph]; sv[j] = tab[(ph + 1536) & 2047]; }
                *(LAS u32x4*)(tc + ml::off_b(r, ch)) = (u32x4){pk2(cv[0], cv[1]), pk2(cv[2], cv[3]), pk2(cv[4], cv[5]), pk2(cv[6], cv[7])};
                *(LAS u32x4*)(tsn + ml::off_b(r, ch)) = (u32x4){pk2(sv[0], sv[1]), pk2(sv[2], sv[3]), pk2(sv[4], sv[5]), pk2(sv[6], sv[7])}; }
        }
        for (int it = blockIdx.x; it < 8 * 16; it += G) {
            const int g = it >> 4, n0 = (it & 15) * 64;
            __syncthreads();
            for (int i = tid; i < 128 * 8; i += NTHR) { const int r = i >> 3, c8 = i & 7; const float* src = W + (size_t)(g * 128 + r) * D + n0 + c8 * 8;
                const f32x4 v0 = *(const f32x4*)src, v1 = *(const f32x4*)(src + 4);
                *(LAS u32x4*)(wt + ml::off_v(r, c8 >> 1) + (c8 & 1) * 16) = (u32x4){pk2(v0.x, v0.y), pk2(v0.z, v0.w), pk2(v1.x, v1.y), pk2(v1.z, v1.w)}; }
            __syncthreads();
            f32x4 dc[4], ds[4];
#pragma unroll
            for (int nt = 0; nt < 4; ++nt) { dc[nt] = (f32x4){0.f, 0.f, 0.f, 0.f}; ds[nt] = dc[nt]; }
#pragma unroll
            for (int ks = 0; ks < 4; ++ks) {
                const ml::bf16x8 fc = *(const LAS ml::bf16x8*)(tc + ml::off_b(16 * wave + fr, 4 * ks + fq)), fs = *(const LAS ml::bf16x8*)(tsn + ml::off_b(16 * wave + fr, 4 * ks + fq));
#pragma unroll
                for (int nt = 0; nt < 4; ++nt) { const ml::bf16x8 wf = ml::tr8_v(wt, lane, nt, ks);
                    dc[nt] = __builtin_amdgcn_mfma_f32_16x16x32_bf16(fc, wf, dc[nt], 0, 0, 0); ds[nt] = __builtin_amdgcn_mfma_f32_16x16x32_bf16(fs, wf, ds[nt], 0, 0, 0); }
            }
#pragma unroll
            for (int nt = 0; nt < 4; ++nt) { bf16* dst = WCS + (size_t)(n0 + 16 * nt + fr) * 2048 + g * 128 + 16 * wave + 4 * fq;
                *(u32x2*)dst = (u32x2){pk2(dc[nt][0], dc[nt][1]), pk2(dc[nt][2], dc[nt][3])};
                *(u32x2*)(dst + 1024) = (u32x2){pk2(ds[nt][0], ds[nt][1]), pk2(ds[nt][2], ds[nt][3])}; }
        }
    }
    __syncthreads();
    {
        LAS float* sc = (LAS float*)lds;
        LAS float* red = (LAS float*)(lds + 40960);
        for (int i = tid; i < 9 * 1024; i += NTHR) { const float v = (i < 8 * 1024) ? a.in[1][i] : a.in[3][i - 8 * 1024]; sc[i] = silu_f(v); }
        __syncthreads();
        float* MOD = (float*)(ws + WS_MOD);
        for (int it = blockIdx.x; it < 2 * 96; it += G) {
            const int l = it / 96, c0 = (it % 96) * 64;
            const float* Wl = a.in[4] + (size_t)l * D * 6144 + c0 + lane;
            float acc[9];
#pragma unroll
            for (int r = 0; r < 9; ++r) acc[r] = 0.f;
            const int kb = wave * 128;
            for (int k4 = 0; k4 < 128; k4 += 32) { float wv[32];
#pragma unroll
                for (int k = 0; k < 32; ++k) wv[k] = Wl[(size_t)(kb + k4 + k) * 6144];
#pragma unroll
                for (int k = 0; k < 32; ++k)
#pragma unroll
                    for (int r = 0; r < 9; ++r) acc[r] += sc[r * 1024 + kb + k4 + k] * wv[k]; }
#pragma unroll
            for (int r = 0; r < 9; ++r) red[(wave * 9 + r) * 64 + lane] = acc[r];
            __syncthreads();
            for (int i = tid; i < 9 * 64; i += NTHR) { float s = 0.f;
#pragma unroll
                for (int w = 0; w < 8; ++w) s += red[w * 576 + i];
                const int r = i >> 6, cl = i & 63;
                MOD[((size_t)l * 9 + r) * 6144 + c0 + cl] = s + a.in[5][(size_t)l * 6144 + c0 + cl]; }
            __syncthreads();
        }
    }
}

__device__ __forceinline__ void load_row_f32(const float* p, int lane, f32x4 (&v)[4]) {
#pragma unroll
    for (int j = 0; j < 4; ++j) v[j] = *(const f32x4*)(p + 4 * lane + 256 * j);
}
__device__ __forceinline__ float row_sumsq(const f32x4 (&v)[4]) {
    float s = 0.f;
#pragma unroll
    for (int j = 0; j < 4; ++j) s += (v[j].x * v[j].x + v[j].y * v[j].y) + (v[j].z * v[j].z + v[j].w * v[j].w);
    return wave_sum(s);
}

__device__ __forceinline__ void p1_norm_mod(const Args& a, int lane, int wave, int G) {
    const float* MOD = (const float*)(a.ws + WS_MOD);
    bf16* A = (bf16*)(a.ws + WS_A);
    const float* g = a.in[6];
    const int gw = blockIdx.x * NWAVES + wave, NGW = G * NWAVES;
    for (int m = gw; m < MALL; m += NGW) {
        const float* xr = (m < ML) ? a.in[0] + (size_t)m * D : a.in[2] + (size_t)(m - ML) * D;
        const int mr = (m < ML) ? (m >> 11) : 8;
        const float* sh = MOD + (size_t)mr * 6144, * sc = sh + D;
        f32x4 v[4]; load_row_f32(xr, lane, v);
        const float rs = rsqrtf(row_sumsq(v) * (1.f / D) + EPS);
#pragma unroll
        for (int j = 0; j < 4; ++j) { const int c = 4 * lane + 256 * j;
            const f32x4 gg = *(const f32x4*)(g + c), s1 = *(const f32x4*)(sc + c), s0 = *(const f32x4*)(sh + c);
            const f32x4 h = v[j] * rs * gg * (1.f + s1) + s0;
            u32x2 o; o.x = pk2(h.x, h.y); o.y = pk2(h.z, h.w);
            *(u32x2*)(A + (size_t)m * D + c) = o; }
    }
}

__device__ __forceinline__ void p4_readout(const Args& a, int lane, int wave, int G) {
    const bf16* HF = (const bf16*)(a.ws + WS_HF); const bf16* HB = (const bf16*)(a.ws + WS_HB); const bf16* O = (const bf16*)(a.ws + WS_O);
    bf16* Y = (bf16*)(a.ws + WS_Y); const float* ng = a.in[16];
    const int gw = blockIdx.x * NWAVES + wave, NGW = G * NWAVES;
    for (int m = gw; m < ML; m += NGW) {
        const size_t off = (size_t)m * D + 16 * lane;
        const u32x4 f0 = *(const u32x4*)(HF + off), f1 = *(const u32x4*)(HF + off + 8);
        const u32x4 b0 = *(const u32x4*)(HB + off), b1 = *(const u32x4*)(HB + off + 8);
        const u32x4 o0 = *(const u32x4*)(O + off), o1 = *(const u32x4*)(O + off + 8);
        float h[16], og[16];
        const unsigned fw[8] = {f0.x, f0.y, f0.z, f0.w, f1.x, f1.y, f1.z, f1.w};
        const unsigned bw[8] = {b0.x, b0.y, b0.z, b0.w, b1.x, b1.y, b1.z, b1.w};
        const unsigned ow[8] = {o0.x, o0.y, o0.z, o0.w, o1.x, o1.y, o1.z, o1.w};
        float ss = 0.f;
#pragma unroll
        for (int j = 0; j < 8; ++j) {
            h[2 * j] = bf2f(fw[j] & 0xffffu) + bf2f(bw[j] & 0xffffu); h[2 * j + 1] = bf2f(fw[j] >> 16) + bf2f(bw[j] >> 16);
            og[2 * j] = bf2f(ow[j] & 0xffffu); og[2 * j + 1] = bf2f(ow[j] >> 16);
            ss += h[2 * j] * h[2 * j] + h[2 * j + 1] * h[2 * j + 1]; }
        ss += __shfl_xor(ss, 1); ss += __shfl_xor(ss, 2); ss += __shfl_xor(ss, 4); ss += __shfl_xor(ss, 8);
        const float rs = rsqrtf(ss * (1.f / DV) + EPS);
        unsigned w[8];
#pragma unroll
        for (int j = 0; j < 8; ++j) {
            const float y0 = h[2 * j] * rs * ng[16 * lane + 2 * j] * sigmoid_f(og[2 * j]);
            const float y1 = h[2 * j + 1] * rs * ng[16 * lane + 2 * j + 1] * sigmoid_f(og[2 * j + 1]);
            w[j] = pk2(y0, y1); }
        *(u32x4*)(Y + off) = (u32x4){w[0], w[1], w[2], w[3]}; *(u32x4*)(Y + off + 8) = (u32x4){w[4], w[5], w[6], w[7]};
    }
}

template <int NEXT>
__device__ __forceinline__ void rowpass(const float* Y, const float* xin, float* xout, const float* gate  , const float* post_g,
                                        const float* ng, const float* shp, const float* scp, bf16* Hout, int lane, int wave, int G) {
    const int gw = blockIdx.x * NWAVES + wave, NGW = G * NWAVES;
    for (int m = gw; m < ML; m += NGW) {
        const int b = m >> 11;
        f32x4 y[4], x[4]; load_row_f32(Y + (size_t)m * D, lane, y); load_row_f32(xin + (size_t)m * D, lane, x);
        const float rs = rsqrtf(row_sumsq(y) * (1.f / D) + EPS);
#pragma unroll
        for (int j = 0; j < 4; ++j) { const int c = 4 * lane + 256 * j;
            const f32x4 gt = *(const f32x4*)(gate + (size_t)b * 6144 + c), pg = *(const f32x4*)(post_g + c);
            x[j] = x[j] + gt * (y[j] * rs * pg);
            *(f32x4*)(xout + (size_t)m * D + c) = x[j]; }
        if (NEXT == 1) {
            const float rs2 = rsqrtf(row_sumsq(x) * (1.f / D) + EPS);
#pragma unroll
            for (int j = 0; j < 4; ++j) { const int c = 4 * lane + 256 * j;
                const f32x4 gg = *(const f32x4*)(ng + c), s1 = *(const f32x4*)(scp + (size_t)b * 6144 + c), s0 = *(const f32x4*)(shp + (size_t)b * 6144 + c);
                const f32x4 h = x[j] * rs2 * gg * (1.f + s1) + s0;
                u32x2 o; o.x = pk2(h.x, h.y); o.y = pk2(h.z, h.w);
                *(u32x2*)(Hout + (size_t)m * D + c) = o; }
        }
    }
}
__device__ __forceinline__ void rowpass_t(const float* Y, const float* xin, float* xout, const float* gate, const float* post_g,
                                          const float* ng, const float* shp, const float* scp, bf16* HT, LAS unsigned char* lds, int tid, int lane, int wave, int G) {
    constexpr int PITCH = 1024 + 8;
    LAS bf16* tile = (LAS bf16*)lds;
    for (int it = blockIdx.x; it < ML / 64; it += G) {
        const int m0 = it * 64, b = m0 >> 11, t0 = m0 & 2047;
        __syncthreads();
        for (int rr = 0; rr < 8; ++rr) {
            const int r = wave * 8 + rr, m = m0 + r;
            f32x4 y[4], x[4]; load_row_f32(Y + (size_t)m * D, lane, y); load_row_f32(xin + (size_t)m * D, lane, x);
            const float rs = rsqrtf(row_sumsq(y) * (1.f / D) + EPS);
#pragma unroll
            for (int j = 0; j < 4; ++j) { const int c = 4 * lane + 256 * j;
                const f32x4 gt = *(const f32x4*)(gate + (size_t)b * 6144 + c), pg = *(const f32x4*)(post_g + c);
                x[j] = x[j] + gt * (y[j] * rs * pg);
                *(f32x4*)(xout + (size_t)m * D + c) = x[j]; }
            const float rs2 = rsqrtf(row_sumsq(x) * (1.f / D) + EPS);
#pragma unroll
            for (int j = 0; j < 4; ++j) { const int c = 4 * lane + 256 * j;
                const f32x4 gg = *(const f32x4*)(ng + c), s1 = *(const f32x4*)(scp + (size_t)b * 6144 + c), s0 = *(const f32x4*)(shp + (size_t)b * 6144 + c);
                const f32x4 h = x[j] * rs2 * gg * (1.f + s1) + s0;
                u32x2 o; o.x = pk2(h.x, h.y); o.y = pk2(h.z, h.w);
                *(LAS u32x2*)(tile + r * PITCH + c) = o; }
        }
        __syncthreads();
        unsigned lo[32], hi[32];
#pragma unroll
        for (int t = 0; t < 64; t += 2) {
            const unsigned w0 = *(const LAS unsigned*)(tile + t * PITCH + 2 * tid), w1 = *(const LAS unsigned*)(tile + (t + 1) * PITCH + 2 * tid);
            lo[t >> 1] = (w0 & 0xffffu) | (w1 << 16); hi[t >> 1] = (w0 >> 16) | (w1 & 0xffff0000u); }
        bf16* d0 = HT + ((size_t)b * D + 2 * tid) * T + t0; bf16* d1 = d0 + T;
#pragma unroll
        for (int q = 0; q < 8; ++q) { *(u32x4*)(d0 + 8 * q) = (u32x4){lo[4 * q], lo[4 * q + 1], lo[4 * q + 2], lo[4 * q + 3]};
                                      *(u32x4*)(d1 + 8 * q) = (u32x4){hi[4 * q], hi[4 * q + 1], hi[4 * q + 2], hi[4 * q + 3]}; }
    }
}

__device__ __forceinline__ void ngemm_tile(const bf16* A, int lda, const bf16* Bt, int ldb, int K, LAS float* sA, LAS float* sB, int tid, float (&acc)[4][4]) {
#pragma unroll
    for (int i = 0; i < 4; ++i)
#pragma unroll
        for (int j = 0; j < 4; ++j) acc[i][j] = 0.f;
    const int ty = tid >> 4, tx = tid & 15;
    for (int k0 = 0; k0 < K; k0 += 32) {
        { const u32x4 v = *(const u32x4*)(A + (size_t)(tid >> 2) * lda + k0 + (tid & 3) * 8);
          LAS float* d = sA + (tid >> 2) * 33 + (tid & 3) * 8;
          d[0] = bf2f(v.x & 0xffffu); d[1] = bf2f(v.x >> 16); d[2] = bf2f(v.y & 0xffffu); d[3] = bf2f(v.y >> 16);
          d[4] = bf2f(v.z & 0xffffu); d[5] = bf2f(v.z >> 16); d[6] = bf2f(v.w & 0xffffu); d[7] = bf2f(v.w >> 16); }
        { const u32x2 v = *(const u32x2*)(Bt + (size_t)(tid >> 3) * ldb + k0 + (tid & 7) * 4);
          LAS float* d = sB + (tid >> 3) * 33 + (tid & 7) * 4;
          d[0] = bf2f(v.x & 0xffffu); d[1] = bf2f(v.x >> 16); d[2] = bf2f(v.y & 0xffffu); d[3] = bf2f(v.y >> 16); }
        __syncthreads();
#pragma unroll 8
        for (int k = 0; k < 32; ++k) {
            float av[4], bv[4];
#pragma unroll
            for (int i = 0; i < 4; ++i) { av[i] = sA[(4 * ty + i) * 33 + k]; bv[i] = sB[(4 * tx + i) * 33 + k]; }
#pragma unroll
            for (int i = 0; i < 4; ++i)
#pragma unroll
                for (int j = 0; j < 4; ++j) acc[i][j] += av[i] * bv[j];
        }
        __syncthreads();
    }
}

__device__ __forceinline__ void p2_inproj_simple(const Args& a, LAS unsigned char* lds, int tid, int G) {
    LAS float* sA = (LAS float*)lds; LAS float* sB = sA + 128 * 33;
    const bf16* A = (const bf16*)(a.ws + WS_A); const bf16* W = (const bf16*)(a.ws + WS_WIN);
    bf16* Q = (bf16*)(a.ws + WS_Q); bf16* Kb = (bf16*)(a.ws + WS_K); bf16* V = (bf16*)(a.ws + WS_V); bf16* O = (bf16*)(a.ws + WS_O); float* Gt = (float*)(a.ws + WS_G);
    const float* bias = a.in[15];
    constexpr int NCB = 49;
    const int ty = tid >> 4, tx = tid & 15;
    for (int it = blockIdx.x; it < (MALL / 128) * NCB; it += G) {
        const int rt = it / NCB, cb = it % NCB, row0 = rt * 128, col0 = cb * 64;
        float acc[4][4];
        ngemm_tile(A + (size_t)row0 * D, D, W + (size_t)col0 * D, D, D, sA, sB, tid, acc);
#pragma unroll
        for (int i = 0; i < 4; ++i)
#pragma unroll
            for (int j = 0; j < 4; ++j) {
                const int r = row0 + 4 * ty + i, c = col0 + 4 * tx + j;
                if (c >= NPROJ) continue;
                const float v = acc[i][j] + bias[c];
                if (c < 512) { if (r < ML) Q[(size_t)r * 512 + c] = (bf16)f2bf(v); }
                else if (c < 1024) Kb[(size_t)r * 512 + (c - 512)] = (bf16)f2bf(v * 0.08838834764831845f);
                else if (c < 2048) V[(size_t)r * D + (c - 1024)] = (bf16)f2bf(v);
                else if (c < 3072) { if (r < ML) O[(size_t)r * D + (c - 2048)] = (bf16)f2bf(v); }
                else Gt[(size_t)r * 16 + (c - 3072)] = v;
            }
    }
}

__device__ __forceinline__ void gemm_simple_f32(const bf16* A, int lda, const bf16* Bt, int ldb, int M, int N, int K, float* C, int ldc, const float* bias, LAS unsigned char* lds, int tid, int G) {
    LAS float* sA = (LAS float*)lds; LAS float* sB = sA + 128 * 33;
    const int ty = tid >> 4, tx = tid & 15, ncb = N / 64;
    for (int it = blockIdx.x; it < (M / 128) * ncb; it += G) {
        const int rt = it / ncb, cb = it % ncb, row0 = rt * 128, col0 = cb * 64;
        float acc[4][4];
        ngemm_tile(A + (size_t)row0 * lda, lda, Bt + (size_t)col0 * ldb, ldb, K, sA, sB, tid, acc);
#pragma unroll
        for (int i = 0; i < 4; ++i) { f32x4 o = {acc[i][0], acc[i][1], acc[i][2], acc[i][3]};
            if (bias) o = o + *(const f32x4*)(bias + col0 + 4 * tx);
            *(f32x4*)(C + (size_t)(row0 + 4 * ty + i) * ldc + col0 + 4 * tx) = o; }
    }
}

__device__ __forceinline__ void p7_up_simple(const bf16* A, const bf16* W  , const float* cw  , const float* cb, bf16* ACT, LAS unsigned char* lds, int tid, int G) {
    LAS float* sA = (LAS float*)lds; LAS float* sB = sA + 128 * 33; LAS float* gs = sB + 64 * 33;
    const int ty = tid >> 4, tx = tid & 15;
    constexpr int NCB = FF / 64;
    for (int it = blockIdx.x; it < (ML / 128) * NCB; it += G) {
        const int rt = it / NCB, jb = it % NCB, row0 = rt * 128, j0 = jb * 64;
        const int wrow = (jb >> 1) * 256 + (jb & 1) * 64;
        float u[4][4], g[4][4];
        ngemm_tile(A + (size_t)row0 * D, D, W + (size_t)wrow * D, D, D, sA, sB, tid, u);
        ngemm_tile(A + (size_t)row0 * D, D, W + (size_t)(wrow + 128) * D, D, D, sA, sB, tid, g);
#pragma unroll
        for (int i = 0; i < 4; ++i)
#pragma unroll
            for (int j = 0; j < 4; ++j) gs[(4 * ty + i) * 65 + 4 * tx + j] = g[i][j];
        __syncthreads();
#pragma unroll
        for (int i = 0; i < 4; ++i)
#pragma unroll
            for (int j = 0; j < 4; ++j) {
                const int rl = 4 * ty + i, cl = 4 * tx + j, f = j0 + cl;
                const float gm = (rl & 63) ? gs[(rl - 1) * 65 + cl] : 0.f, gp = ((rl & 63) != 63) ? gs[(rl + 1) * 65 + cl] : 0.f;
                const float gc = gm * cw[f] + g[i][j] * cw[FF + f] + gp * cw[2 * FF + f] + cb[f];
                ACT[(size_t)(row0 + rl) * FF + f] = (bf16)f2bf(silu_f(gc) * u[i][j]);
            }
        __syncthreads();
    }
}

__device__ __forceinline__ void p10_seqmix_simple(const Args& a, LAS unsigned char* lds, int tid, int G) {
    LAS float* sA = (LAS float*)lds; LAS float* sB = sA + 128 * 33;
    const bf16* DF = (const bf16*)(a.ws + WS_DFT); const bf16* HT = (const bf16*)(a.ws + WS_HT); bf16* PQ = (bf16*)(a.ws + WS_PQ);
    const int ty = tid >> 4, tx = tid & 15;
    for (int it = blockIdx.x; it < 8 * 32 * 16; it += G) {
        const int b = it >> 9, rt = (it >> 4) & 31, cbk = it & 15, r0 = rt * 128, c0 = cbk * 64;
        float acc[4][4];
        ngemm_tile(DF + (size_t)r0 * 2048, 2048, HT + ((size_t)b * D + c0) * T, T, 2048, sA, sB, tid, acc);
        const int kind = r0 >> 11, tp0 = r0 & 2047;
#pragma unroll
        for (int i = 0; i < 4; ++i) { u32x2 o; o.x = pk2(acc[i][0], acc[i][1]); o.y = pk2(acc[i][2], acc[i][3]);
            *(u32x2*)(PQ + (size_t)(b * 2048 + tp0 + 4 * ty + i) * 2048 + kind * 1024 + c0 + 4 * tx) = o; }
    }
}

__device__ __forceinline__ void p3_mlstm_simple(const Args& a, LAS unsigned char* lds, int tid, int G) {
    const bf16* Q = (const bf16*)(a.ws + WS_Q); const bf16* Kb = (const bf16*)(a.ws + WS_K); const bf16* V = (const bf16*)(a.ws + WS_V); const float* Gt = (const float*)(a.ws + WS_G);
    LAS float* sq = (LAS float*)lds;
    LAS float* sk = sq + 64 * 128;
    LAS float* sv = sk + 64 * 128;
    LAS float* sg = sv + 64 * 32;
    const int j = tid >> 4, g = tid & 15;
    for (int it = blockIdx.x; it < 64 * 8; it += G) {
        const int bh = it >> 4, dir = (it >> 3) & 1, dvb = it & 7, b = bh >> 2, h = bh & 3;
        bf16* Hout = (bf16*)(a.ws + (dir ? WS_HB : WS_HF));
        float Cst[8], nst[8];
#pragma unroll
        for (int d = 0; d < 8; ++d) { Cst[d] = 0.f; nst[d] = 0.f; }
        for (int sb = 0; sb < 36; ++sb) {
            const bool isctx = sb < 4;
            const int nblk = isctx ? 4 : 32, bi = isctx ? sb : sb - 4;
            const int blk = dir ? (nblk - 1 - bi) : bi;
            const int rowbase = isctx ? (ML + b * TC + blk * 64) : (b * T + blk * 64);
            __syncthreads();
            for (int i = tid; i < 64 * 128; i += NTHR) { const int p = i >> 7, c = i & 127; const int tok = rowbase + (dir ? 63 - p : p);
                sk[i] = bf2f(Kb[(size_t)tok * 512 + h * 128 + c]);
                sq[i] = isctx ? 0.f : bf2f(Q[(size_t)tok * 512 + h * 128 + c]); }
            for (int i = tid; i < 64 * 32; i += NTHR) { const int p = i >> 5, c = i & 31; const int tok = rowbase + (dir ? 63 - p : p);
                sv[i] = bf2f(V[(size_t)tok * D + h * 256 + dvb * 32 + c]); }
            if (tid < 64) { const int tok = rowbase + (dir ? 63 - tid : tid);
                sg[2 * tid] = __expf(Gt[(size_t)tok * 16 + dir * 8 + h]); sg[2 * tid + 1] = __expf(logsigmoid_f(Gt[(size_t)tok * 16 + dir * 8 + 4 + h])); }
            __syncthreads();
            for (int p = 0; p < 64; ++p) {
                const float iv = sg[2 * p], fv = sg[2 * p + 1], vv = sv[p * 32 + j];
                float pn = 0.f, pd = 0.f;
#pragma unroll
                for (int d = 0; d < 8; ++d) { const float kk = sk[p * 128 + 8 * g + d], qq = sq[p * 128 + 8 * g + d];
                    Cst[d] = fv * Cst[d] + iv * kk * vv; nst[d] = fv * nst[d] + iv * kk;
                    pn += qq * Cst[d]; pd += qq * nst[d]; }
                if (!isctx) {
                    pn += __shfl_xor(pn, 1); pn += __shfl_xor(pn, 2); pn += __shfl_xor(pn, 4); pn += __shfl_xor(pn, 8);
                    pd += __shfl_xor(pd, 1); pd += __shfl_xor(pd, 2); pd += __shfl_xor(pd, 4); pd += __shfl_xor(pd, 8);
                    if (g == 0) { const int tok = rowbase + (dir ? 63 - p : p);
                        Hout[(size_t)tok * D + h * 256 + dvb * 32 + j] = (bf16)f2bf(pn / fmaxf(fabsf(pd), 1.0f)); }
                }
            }
        }
    }
}


namespace ml {
constexpr int L_K = 0, L_V = 32768, L_VS = 49152, L_CT = 65536, L_ST = 86016, L_G = 102400, G_STRIDE = 3072;
__device__ __forceinline__ void mlstm_phase(const Args& a, LAS unsigned char* lds, int tid, int lane, int wave, int G) {
    const bf16* Qg = (const bf16*)(a.ws + WS_Q); const bf16* Kg = (const bf16*)(a.ws + WS_K); const bf16* Vg = (const bf16*)(a.ws + WS_V); const float* Gt = (const float*)(a.ws + WS_G);
    const int fr = lane & 15, fq = lane >> 4;
    const int vcu = (G % 8 == 0) ? ((int)blockIdx.x % 8) * (G / 8) + (int)blockIdx.x / 8 : (int)blockIdx.x;
    for (int it = vcu; it < 256; it += G) {
        const int dvq = it & 3, dir = (it >> 2) & 1, bh = it >> 3, b = bh >> 2, h = bh & 3;
        bf16* Hout = (bf16*)(a.ws + (dir ? WS_HB : WS_HF));
        auto chunk_base = [&](int ci) -> int { return ci < 2 ? (ML + b * TC + (dir ? 1 - ci : ci) * 128) : (b * T + (dir ? 15 - (ci - 2) : (ci - 2)) * 128); };
        __syncthreads();
        for (int i = tid; i < 20480 / 16; i += NTHR) *(LAS u32x4*)(lds + L_CT + 16 * i) = (u32x4){0u, 0u, 0u, 0u};
        f32x4 cacc[5];
#pragma unroll
        for (int t5 = 0; t5 < 5; ++t5) cacc[t5] = (f32x4){0.f, 0.f, 0.f, 0.f};
        float mstate = 0.f;
        u32x4 kreg[4], vreg[2]; bf16x8 qf[4], qn[4];
#pragma unroll
        for (int i = 0; i < 4; ++i) { qf[i] = (bf16x8){0, 0, 0, 0, 0, 0, 0, 0}; qn[i] = qf[i]; }

        auto gate_scan = [&](int ci) {
            const int base = chunk_base(ci);
            LAS float* gb = (LAS float*)(lds + L_G + (ci & 1) * G_STRIDE);
            const int r0 = lane, r1 = lane + 64;
            const int t0 = base + (dir ? 127 - r0 : r0), t1 = base + (dir ? 127 - r1 : r1);
            const float li0 = Gt[(size_t)t0 * 16 + dir * 8 + h], li1 = Gt[(size_t)t1 * 16 + dir * 8 + h];
            float s0 = logsigmoid_f(Gt[(size_t)t0 * 16 + dir * 8 + 4 + h]), s1 = logsigmoid_f(Gt[(size_t)t1 * 16 + dir * 8 + 4 + h]);
#pragma unroll
            for (int d = 1; d < 64; d <<= 1) { const float x0 = __shfl_up(s0, d), x1 = __shfl_up(s1, d); if (lane >= d) { s0 += x0; s1 += x1; } }
            s1 += __shfl(s0, 63);
            const float u0 = li0 - s0, u1 = li1 - s1;
            float c0 = u0, c1 = u1;
#pragma unroll
            for (int d = 1; d < 64; d <<= 1) { const float x0 = __shfl_up(c0, d), x1 = __shfl_up(c1, d); if (lane >= d) { c0 = fmaxf(c0, x0); c1 = fmaxf(c1, x1); } }
            c1 = fmaxf(c1, __shfl(c0, 63));
            const float m = mstate, M0 = fmaxf(m, c0), M1 = fmaxf(m, c1), MLs = __shfl(M1, 63), bL = __shfl(s1, 63);
            gb[r0] = u0; gb[r1] = u1; gb[128 + r0] = M0; gb[128 + r1] = M1;
            gb[256 + r0] = __expf(-(s0 + M0)); gb[256 + r1] = __expf(-(s1 + M1));
            gb[384 + r0] = __expf(u0 - MLs); gb[384 + r1] = __expf(u1 - MLs);
            gb[512 + r0] = __expf(m - M0); gb[512 + r1] = __expf(m - M1);
            if (lane == 0) gb[640] = __expf(m - MLs);
            mstate = bL + MLs;
        };
        auto prefetch = [&](int ci) {
            const int base = chunk_base(ci);
#pragma unroll
            for (int i = 0; i < 4; ++i) { const int p = tid + 512 * i, row = p >> 4, ch = p & 15; const int tok = base + (dir ? 127 - row : row);
                kreg[i] = *(const u32x4*)(Kg + (size_t)tok * 512 + h * 128 + ch * 8); }
#pragma unroll
            for (int i = 0; i < 2; ++i) { const int p = tid + 512 * i, row = p >> 3, c8 = p & 7; const int tok = base + (dir ? 127 - row : row);
                vreg[i] = *(const u32x4*)(Vg + (size_t)tok * D + h * 256 + dvq * 64 + c8 * 8); }
        };
        auto prefetch_q = [&](int ci) {
            const int base = chunk_base(ci); const int t = 16 * wave + fr; const int tok = base + (dir ? 127 - t : t);
#pragma unroll
            for (int ks = 0; ks < 4; ++ks) qn[ks] = *(const bf16x8*)(Qg + (size_t)tok * 512 + h * 128 + 32 * ks + 8 * fq);
        };
        auto stage = [&](int ci) {
            const LAS float* gb = (const LAS float*)(lds + L_G + (ci & 1) * G_STRIDE);
#pragma unroll
            for (int i = 0; i < 4; ++i) { const int p = tid + 512 * i, row = p >> 4, ch = p & 15; *(LAS u32x4*)(lds + L_K + off_b(row, ch)) = kreg[i]; }
#pragma unroll
            for (int i = 0; i < 2; ++i) { const int p = tid + 512 * i, row = p >> 3, c8 = p & 7; const unsigned o = off_v(row, c8 >> 1) + (c8 & 1) * 16;
                *(LAS u32x4*)(lds + L_V + o) = vreg[i];
                const float w = gb[384 + row]; const u32x4 v = vreg[i]; u32x4 sv;
                sv.x = cvt_pk(bf2f(v.x & 0xffffu) * w, bf2f(v.x >> 16) * w); sv.y = cvt_pk(bf2f(v.y & 0xffffu) * w, bf2f(v.y >> 16) * w);
                sv.z = cvt_pk(bf2f(v.z & 0xffffu) * w, bf2f(v.z >> 16) * w); sv.w = cvt_pk(bf2f(v.w & 0xffffu) * w, bf2f(v.w >> 16) * w);
                *(LAS u32x4*)(lds + L_VS + o) = sv; }
        };

        prefetch(0);
        if (wave == 0) gate_scan(0);
        __syncthreads();
        stage(0);
        __syncthreads();

        for (int ci = 0; ci < 18; ++ci) {
            const bool latent = ci >= 2, has_next = ci < 17;
            const LAS float* gb = (const LAS float*)(lds + L_G + (ci & 1) * G_STRIDE);
            if (has_next) { prefetch(ci + 1); if (ci + 1 >= 2) prefetch_q(ci + 1); }
            if (wave == 0 && has_next) gate_scan(ci + 1);
            if (latent) {
                const int t = 16 * wave + fr;
                const float Mt = gb[128 + t], wit = gb[512 + t], flt = gb[256 + t];
                f32x4 acc[5];
#pragma unroll
                for (int t5 = 0; t5 < 5; ++t5) acc[t5] = (f32x4){0.f, 0.f, 0.f, 0.f};
#pragma unroll
                for (int ks = 0; ks < 4; ++ks)
#pragma unroll
                    for (int t5 = 0; t5 < 5; ++t5) { const bf16x8 cf = *(const LAS bf16x8*)(lds + L_CT + off_b(fr + 16 * t5, 4 * ks + fq));
                        acc[t5] = __builtin_amdgcn_mfma_f32_16x16x32_bf16(cf, qf[ks], acc[t5], 0, 0, 0); }
#pragma unroll
                for (int t5 = 0; t5 < 5; ++t5) acc[t5] = acc[t5] * wit;
                for (int jp = 0; jp <= (wave >> 1); ++jp) {
                    f32x4 s_lo = {0.f, 0.f, 0.f, 0.f}, s_hi = {0.f, 0.f, 0.f, 0.f};
                    const int krow = 32 * jp + 8 * (fr >> 2) + (fr & 3);
#pragma unroll
                    for (int ks = 0; ks < 4; ++ks) {
                        const bf16x8 k_lo = *(const LAS bf16x8*)(lds + L_K + off_b(krow, 4 * ks + fq)), k_hi = *(const LAS bf16x8*)(lds + L_K + off_b(krow + 4, 4 * ks + fq));
                        s_lo = __builtin_amdgcn_mfma_f32_16x16x32_bf16(k_lo, qf[ks], s_lo, 0, 0, 0);
                        s_hi = __builtin_amdgcn_mfma_f32_16x16x32_bf16(k_hi, qf[ks], s_hi, 0, 0, 0);
                    }
                    const int sb = 32 * jp + 8 * fq;
                    const f32x4 u_lo = *(const LAS f32x4*)(gb + sb), u_hi = *(const LAS f32x4*)(gb + sb + 4);
                    float pv[8];
#pragma unroll
                    for (int e = 0; e < 4; ++e) { pv[e] = (sb + e <= t) ? s_lo[e] * __expf(u_lo[e] - Mt) : 0.f; pv[4 + e] = (sb + 4 + e <= t) ? s_hi[e] * __expf(u_hi[e] - Mt) : 0.f; }
                    u32x4 pw; pw.x = cvt_pk(pv[0], pv[1]); pw.y = cvt_pk(pv[2], pv[3]); pw.z = cvt_pk(pv[4], pv[5]); pw.w = cvt_pk(pv[6], pv[7]);
                    const bf16x8 sfrag = __builtin_bit_cast(bf16x8, pw);
#pragma unroll
                    for (int t5 = 0; t5 < 4; ++t5) { const bf16x8 vf = tr8_v(lds + L_V, lane, t5, jp); acc[t5] = __builtin_amdgcn_mfma_f32_16x16x32_bf16(vf, sfrag, acc[t5], 0, 0, 0); }
                    const short one = (fr == 0) ? (short)0x3F80 : (short)0;
                    const bf16x8 of = {one, one, one, one, one, one, one, one};
                    acc[4] = __builtin_amdgcn_mfma_f32_16x16x32_bf16(of, sfrag, acc[4], 0, 0, 0);
                }
                const float den = __shfl(acc[4][0], fr);
                const float inv = 1.0f / fmaxf(fabsf(den), flt);
#pragma unroll
                for (int t5 = 0; t5 < 4; ++t5) { u32x2 o; o.x = cvt_pk(acc[t5][0] * inv, acc[t5][1] * inv); o.y = cvt_pk(acc[t5][2] * inv, acc[t5][3] * inv);
                    *(LAS u32x2*)(lds + L_ST + t * 128 + (16 * t5 + 4 * fq) * 2) = o; }
                asm volatile("s_waitcnt lgkmcnt(0)" ::: "memory");
                { const int row = 16 * wave + (lane >> 2), cb = (lane & 3) * 32; const int base = chunk_base(ci); const int tok = base + (dir ? 127 - row : row);
                  const u32x4 o0 = *(const LAS u32x4*)(lds + L_ST + row * 128 + cb), o1 = *(const LAS u32x4*)(lds + L_ST + row * 128 + cb + 16);
                  bf16* dst = Hout + (size_t)tok * D + h * 256 + dvq * 64 + (lane & 3) * 16;
                  *(u32x4*)dst = o0; *(u32x4*)(dst + 8) = o1; }
            }
            if (has_next) {
                const float av = gb[640];
#pragma unroll
                for (int t5 = 0; t5 < 5; ++t5) cacc[t5] = cacc[t5] * av;
#pragma unroll
                for (int ks = 0; ks < 4; ++ks) {
                    const bf16x8 kt = tr8_b(lds + L_K, lane, wave, ks);
#pragma unroll
                    for (int t5 = 0; t5 < 4; ++t5) { const bf16x8 vs = tr8_v(lds + L_VS, lane, t5, ks); cacc[t5] = __builtin_amdgcn_mfma_f32_16x16x32_bf16(kt, vs, cacc[t5], 0, 0, 0); }
                    const f32x4 w_lo = *(const LAS f32x4*)(gb + 384 + 32 * ks + 8 * fq), w_hi = *(const LAS f32x4*)(gb + 384 + 32 * ks + 8 * fq + 4);
                    u32x4 ww; ww.x = cvt_pk(w_lo[0], w_lo[1]); ww.y = cvt_pk(w_lo[2], w_lo[3]); ww.z = cvt_pk(w_hi[0], w_hi[1]); ww.w = cvt_pk(w_hi[2], w_hi[3]);
                    if (fr != 0) ww = (u32x4){0u, 0u, 0u, 0u};
                    cacc[4] = __builtin_amdgcn_mfma_f32_16x16x32_bf16(kt, __builtin_bit_cast(bf16x8, ww), cacc[4], 0, 0, 0);
                }
            }
            __syncthreads();
            if (has_next) {
#pragma unroll
                for (int t5 = 0; t5 < 5; ++t5) { u32x2 o; o.x = cvt_pk(cacc[t5][0], cacc[t5][1]); o.y = cvt_pk(cacc[t5][2], cacc[t5][3]);
                    *(LAS u32x2*)(lds + L_CT + off_b(16 * t5 + fr, 2 * wave + (fq >> 1)) + (fq & 1) * 8) = o; }
                stage(ci + 1);
#pragma unroll
                for (int ks = 0; ks < 4; ++ks) qf[ks] = qn[ks];
            }
            __syncthreads();
        }
    }
}
}

#ifndef FAST_MLSTM
#define FAST_MLSTM 1
#endif

namespace pg8 {
typedef short bf16x8 __attribute__((ext_vector_type(8)));
constexpr int BM = 256, BK = 64, HALF = 128, HTB = HALF * BK * 2, STAGE_BYTES = 8 * HTB, NXCD = 8, WGM = 8;
__host__ __device__ __forceinline__ int lds_byte(int r, int c) { const int st = (r >> 4) * 2 + (c >> 5), rr = r & 15, cc = c & 31, ob = rr * 64 + cc * 2; return st * 1024 + (ob ^ (((ob >> 9) & 1) << 5)); }
__host__ __device__ __forceinline__ void stage_rc(int b, int& R, int& C) { const int st = b / 1024, sb = b % 1024, swz = sb ^ (((sb >> 9) & 1) << 5); R = (st >> 1) * 16 + swz / 64; C = (st & 1) * 32 + (swz % 64) / 2; }
__host__ __device__ __forceinline__ int perm32(int rho) { const int n = rho >> 4, i = rho & 15; return 8 * (i >> 2) + 4 * n + (i & 3); }
struct Unit { int pm, pn; };
struct Gemm { const bf16* A; const bf16* Bt; int lda, ldb, K, mode;
    __device__ __forceinline__ size_t a_off(const Unit& u) const { return mode == 0 ? (size_t)u.pm * 256 * lda : (size_t)(u.pm & 15) * 256 * lda; }
    __device__ __forceinline__ size_t b_off(const Unit& u) const { return mode == 0 ? (size_t)u.pn * 256 * ldb : (size_t)((u.pm >> 4) * 1024 + u.pn * 256) * ldb; }
};
struct StaticOrder {
    int nM, nN, nwg, G, c;
    __device__ __forceinline__ void init(int nM_, int nN_, int G_, int c_) { nM = nM_; nN = nN_; nwg = nM * nN; G = G_; c = c_; }
    __device__ __forceinline__ bool next(int i, Unit& u) const {
        const long L = (long)i * G + c; if (L >= nwg) return false;
        int wgid = (int)L; { const int q = nwg / NXCD, r = nwg % NXCD, xcd = wgid % NXCD, off = wgid / NXCD; wgid = (xcd < r ? xcd * (q + 1) : r * (q + 1) + (xcd - r) * q) + off; }
        const int nig = WGM * nN, gid = wgid / nig, fm = gid * WGM, gsz = (nM - fm) < WGM ? (nM - fm) : WGM;
        u.pm = fm + ((wgid % nig) % gsz); u.pn = (wgid % nig) / gsz; return true;
    }
};
__device__ __forceinline__ unsigned cvt_pk_bf16(float lo, float hi) { unsigned r; asm volatile("v_cvt_pk_bf16_f32 %0, %1, %2" : "=v"(r) : "v"(lo), "v"(hi)); return r; }
__device__ __forceinline__ u32x4 pack8(const f32x4 v0, const f32x4 v1) { u32x4 w; w.x = cvt_pk_bf16(v0[0], v0[1]); w.y = cvt_pk_bf16(v0[2], v0[3]); w.z = cvt_pk_bf16(v1[0], v1[1]); w.w = cvt_pk_bf16(v1[2], v1[3]); return w; }

struct EpiF32 {
    static constexpr bool PERM = false;
    float* C; int ldc; const float* bias;
    __device__ __forceinline__ void operator()(const f32x4 (&acc)[2][2][4][2], const Unit& u, int wr, int wc, int fr, int fq) const {
        const int row0 = u.pm * BM + wr * 64 + fr, col0 = u.pn * BM + wc * 32 + 4 * fq;
        f32x4 bv[2][2];
#pragma unroll
        for (int bj = 0; bj < 2; ++bj)
#pragma unroll
            for (int n = 0; n < 2; ++n) bv[bj][n] = bias ? *(const f32x4*)(bias + col0 + bj * HALF + n * 16) : (f32x4){0.f, 0.f, 0.f, 0.f};
#pragma unroll
        for (int ai = 0; ai < 2; ++ai)
#pragma unroll
            for (int m = 0; m < 4; ++m) { float* rowp = C + (size_t)(row0 + ai * HALF + m * 16) * ldc + col0;
#pragma unroll
                for (int bj = 0; bj < 2; ++bj)
#pragma unroll
                    for (int n = 0; n < 2; ++n) *(f32x4*)(rowp + bj * HALF + n * 16) = acc[ai][bj][m][n] + bv[bj][n]; }
    }
};
struct EpiInProj {
    static constexpr bool PERM = true;
    bf16 *Q, *Kb, *V, *O; float* Gt; const float* bias;
    __device__ __forceinline__ void operator()(const f32x4 (&acc)[2][2][4][2], const Unit& u, int wr, int wc, int fr, int fq) const {
        const int pn = u.pn, pm = u.pm, row0 = pm * BM + wr * 64 + fr;
        if (pn == 12) {
            if (wc == 0 && fq < 2) {
                const f32x4 b0 = *(const f32x4*)(bias + 3072 + 8 * fq), b1 = *(const f32x4*)(bias + 3072 + 8 * fq + 4);
#pragma unroll
                for (int ai = 0; ai < 2; ++ai)
#pragma unroll
                    for (int m = 0; m < 4; ++m) { float* p = Gt + (size_t)(row0 + ai * HALF + m * 16) * 16 + 8 * fq;
                        *(f32x4*)p = acc[ai][0][m][0] + b0; *(f32x4*)(p + 4) = acc[ai][0][m][1] + b1; }
            }
            return;
        }
        if (pm >= 64 && (pn < 2 || pn >= 8)) return;
        bf16* base; int ldc, colt; float sc = 1.f;
        if (pn < 2) { base = Q; ldc = 512; colt = pn * 256; }
        else if (pn < 4) { base = Kb; ldc = 512; colt = (pn - 2) * 256; sc = 0.08838834764831845f; }
        else if (pn < 8) { base = V; ldc = 1024; colt = (pn - 4) * 256; }
        else { base = O; ldc = 1024; colt = (pn - 8) * 256; }
        const int col0 = colt + wc * 32 + 8 * fq, bcol0 = pn * BM + wc * 32 + 8 * fq;
        f32x4 bv[2][2];
#pragma unroll
        for (int bj = 0; bj < 2; ++bj)
#pragma unroll
            for (int n = 0; n < 2; ++n) bv[bj][n] = *(const f32x4*)(bias + bcol0 + bj * HALF + 4 * n);
#pragma unroll
        for (int ai = 0; ai < 2; ++ai)
#pragma unroll
            for (int m = 0; m < 4; ++m) { bf16* rowp = base + (size_t)(row0 + ai * HALF + m * 16) * ldc + col0;
#pragma unroll
                for (int bj = 0; bj < 2; ++bj) { const f32x4 v0 = (acc[ai][bj][m][0] + bv[bj][0]) * sc, v1 = (acc[ai][bj][m][1] + bv[bj][1]) * sc;
                    *(u32x4*)(rowp + bj * HALF) = pack8(v0, v1); } }
    }
};
struct EpiSeqMix {
    static constexpr bool PERM = true;
    bf16* PQ;
    __device__ __forceinline__ void operator()(const f32x4 (&acc)[2][2][4][2], const Unit& u, int wr, int wc, int fr, int fq) const {
        const int b = u.pm >> 4, rt = u.pm & 15;
        const int row0 = b * 2048 + (rt & 7) * 256 + wr * 64 + fr, col0 = (rt >> 3) * 1024 + u.pn * 256 + wc * 32 + 8 * fq;
#pragma unroll
        for (int ai = 0; ai < 2; ++ai)
#pragma unroll
            for (int m = 0; m < 4; ++m) { bf16* rowp = PQ + (size_t)(row0 + ai * HALF + m * 16) * 2048 + col0;
#pragma unroll
                for (int bj = 0; bj < 2; ++bj) *(u32x4*)(rowp + bj * HALF) = pack8(acc[ai][bj][m][0], acc[ai][bj][m][1]); }
    }
};
__device__ __forceinline__ float dpp_ror1(float v) { return __int_as_float(__builtin_amdgcn_update_dpp(0, __float_as_int(v), 0x121, 0xf, 0xf, false)); }
__device__ __forceinline__ float dpp_rol1(float v) { return __int_as_float(__builtin_amdgcn_update_dpp(0, __float_as_int(v), 0x12f, 0xf, 0xf, false)); }
struct EpiUpConv {
    static constexpr bool PERM = true;
    bf16* ACT; const float* cw; const float* cb;
    __device__ __forceinline__ void operator()(const f32x4 (&acc)[2][2][4][2], const Unit& u, int wr, int wc, int fr, int fq) const {
        const int f0 = u.pn * 128 + wc * 32 + 8 * fq, row0 = u.pm * BM + wr * 64 + fr;
        f32x4 w0[2], w1[2], w2[2], bb[2];
#pragma unroll
        for (int n = 0; n < 2; ++n) { w0[n] = *(const f32x4*)(cw + f0 + 4 * n); w1[n] = *(const f32x4*)(cw + FF + f0 + 4 * n); w2[n] = *(const f32x4*)(cw + 2 * FF + f0 + 4 * n); bb[n] = *(const f32x4*)(cb + f0 + 4 * n); }
        const bool first = (fr == 0), last = (fr == 15);
#pragma unroll
        for (int ai = 0; ai < 2; ++ai) {
            f32x4 res[4][2];
#pragma unroll
            for (int n = 0; n < 2; ++n) {
                f32x4 R[4], L[4];
#pragma unroll
                for (int m = 0; m < 4; ++m)
#pragma unroll
                    for (int e = 0; e < 4; ++e) { R[m][e] = dpp_ror1(acc[ai][1][m][n][e]); L[m][e] = dpp_rol1(acc[ai][1][m][n][e]); }
#pragma unroll
                for (int m = 0; m < 4; ++m)
#pragma unroll
                    for (int e = 0; e < 4; ++e) {
                        const float pv = first ? (m > 0 ? R[m > 0 ? m - 1 : 0][e] : 0.f) : R[m][e];
                        const float nv = last ? (m < 3 ? L[m < 3 ? m + 1 : 3][e] : 0.f) : L[m][e];
                        const float gc = pv * w0[n][e] + acc[ai][1][m][n][e] * w1[n][e] + nv * w2[n][e] + bb[n][e];
                        res[m][n][e] = gc * __builtin_amdgcn_rcpf(1.f + __expf(-gc)) * acc[ai][0][m][n][e];
                    }
            }
#pragma unroll
            for (int m = 0; m < 4; ++m) *(u32x4*)(ACT + (size_t)(row0 + ai * HALF + m * 16) * FF + f0) = pack8(res[m][0], res[m][1]);
        }
    }
};

template <class Epi, bool ALIGN_EPI = true>
__device__ __forceinline__ void gemm_phase(LAS unsigned char* lds, const Gemm g, const StaticOrder& S, const Epi& E) {
    const int tid = threadIdx.x, wid = __builtin_amdgcn_readfirstlane(tid >> 6), lane = tid & 63, wr = wid >> 2, wc = wid & 3, fr = lane & 15, fq = lane >> 4;
    const int K = g.K, nt = K / BK;
    unsigned voffA[2], voffB[2];
#pragma unroll
    for (int i = 0; i < 2; ++i) { int R, C; stage_rc(tid * 16 + i * 8192, R, C); const int Rb = Epi::PERM ? ((R & ~31) + perm32(R & 31)) : R;
        voffA[i] = (unsigned)(R * g.lda + C) * 2u; voffB[i] = (unsigned)(Rb * g.ldb + C) * 2u; }
    const size_t kstep = (size_t)(BK * 2);
    const size_t hstepA = (size_t)HALF * g.lda * 2, hstepB = (size_t)HALF * g.ldb * 2;
    const unsigned ldsw = (unsigned)wid * 1024u;
    const int aoff = lds_byte(wr * 64 + fr, fq * 8), boff = lds_byte(wc * 32 + fr, fq * 8);
#define PG8_SA(b, h) (((b) * 2 + (h)) * HTB)
#define PG8_SB(b, h) ((4 + (b) * 2 + (h)) * HTB)
#define PG8_STAGE(bufoff, gbase, voff) do { _Pragma("unroll") for (int _i = 0; _i < 2; ++_i) \
        __builtin_amdgcn_global_load_lds((const unsigned*)((const char*)(gbase) + (voff)[_i]), (LAS unsigned*)(lds + (bufoff) + ldsw + _i * 8192), 16, 0, 0); } while (0)
#define PG8_LDA(dst, b, h) do { _Pragma("unroll") for (int m = 0; m < 4; ++m) _Pragma("unroll") for (int k = 0; k < 2; ++k) dst[m][k] = *(const LAS bf16x8*)(lds + PG8_SA(b, h) + aoff + m * 2048 + k * 1024); } while (0)
#define PG8_LDB(dst, b, h) do { _Pragma("unroll") for (int n = 0; n < 2; ++n) _Pragma("unroll") for (int k = 0; k < 2; ++k) dst[n][k] = *(const LAS bf16x8*)(lds + PG8_SB(b, h) + boff + n * 2048 + k * 1024); } while (0)
#define PG8_MMA(ai, bj, At, Bt) do { __builtin_amdgcn_s_setprio(1); _Pragma("unroll") for (int m = 0; m < 4; ++m) _Pragma("unroll") for (int n = 0; n < 2; ++n) _Pragma("unroll") for (int k = 0; k < 2; ++k) \
        acc[ai][bj][m][n] = __builtin_amdgcn_mfma_f32_16x16x32_bf16(Bt[n][k], At[m][k], acc[ai][bj][m][n], 0, 0, 0); __builtin_amdgcn_s_setprio(0); } while (0)
#define PG8_WAIT_V(n) asm volatile("s_waitcnt vmcnt(" #n ")" ::: "memory")
#define PG8_WAIT_L(n) asm volatile("s_waitcnt lgkmcnt(" #n ")" ::: "memory")
#define PG8_BAR __builtin_amdgcn_s_barrier()
#define PG8_SCHED __builtin_amdgcn_sched_barrier(0)
    Unit cur, nxt; int ui = 0;
    if (!S.next(0, cur)) return;
    f32x4 acc[2][2][4][2];
#pragma unroll
    for (int a = 0; a < 2; ++a)
#pragma unroll
        for (int b = 0; b < 2; ++b)
#pragma unroll
            for (int m = 0; m < 4; ++m)
#pragma unroll
                for (int n = 0; n < 2; ++n) acc[a][b][m][n] = (f32x4){0.f, 0.f, 0.f, 0.f};
    bf16x8 At[4][2], B0[2][2], B1[2][2];
    const char* cA = (const char*)g.A + g.a_off(cur) * 2; const char* cB = (const char*)g.Bt + g.b_off(cur) * 2;
    PG8_STAGE(PG8_SB(0, 0), cB, voffB); PG8_STAGE(PG8_SB(0, 1), cB + hstepB, voffB); PG8_STAGE(PG8_SA(0, 0), cA, voffA); PG8_STAGE(PG8_SA(0, 1), cA + hstepA, voffA);
    if (wr == 1) PG8_BAR;
    PG8_WAIT_V(2); PG8_BAR;
    PG8_STAGE(PG8_SB(1, 0), cB + kstep, voffB); PG8_STAGE(PG8_SA(1, 0), cA + kstep, voffA); PG8_STAGE(PG8_SB(1, 1), cB + hstepB + kstep, voffB);
    PG8_WAIT_V(6); PG8_BAR;
    for (;;) {
        const bool has_next = S.next(ui + 1, nxt);
        const char* nA = has_next ? (const char*)g.A + g.a_off(nxt) * 2 : cA; const char* nB = has_next ? (const char*)g.Bt + g.b_off(nxt) * 2 : cB;
        for (int t = 0; t < nt; t += 2) {
            const bool last = (t == nt - 2);
            const char* a1 = cA + (size_t)(t + 1) * kstep;
            const char* a2 = last ? nA : cA + (size_t)(t + 2) * kstep; const char* b2 = last ? nB : cB + (size_t)(t + 2) * kstep;
            const char* a3 = a2 + kstep; const char* b3 = b2 + kstep;
            PG8_LDB(B0, 0, 0); PG8_LDB(B1, 0, 1); PG8_SCHED; PG8_LDA(At, 0, 0); PG8_STAGE(PG8_SA(1, 1), a1 + hstepA, voffA);
            PG8_WAIT_V(8); PG8_WAIT_L(0); PG8_BAR; PG8_MMA(0, 0, At, B0); PG8_MMA(0, 1, At, B1); PG8_BAR; PG8_SCHED;
            PG8_LDA(At, 0, 1); PG8_STAGE(PG8_SB(0, 0), b2, voffB); PG8_STAGE(PG8_SB(0, 1), b2 + hstepB, voffB); PG8_STAGE(PG8_SA(0, 0), a2, voffA);
            PG8_WAIT_V(8); PG8_WAIT_L(0); PG8_BAR; PG8_MMA(1, 0, At, B0); PG8_MMA(1, 1, At, B1); PG8_BAR; PG8_SCHED;
            PG8_LDB(B0, 1, 0); PG8_LDB(B1, 1, 1); PG8_SCHED; PG8_LDA(At, 1, 0); PG8_STAGE(PG8_SA(0, 1), a2 + hstepA, voffA);
            PG8_WAIT_V(8); PG8_WAIT_L(0); PG8_BAR; PG8_MMA(0, 0, At, B0); PG8_MMA(0, 1, At, B1); PG8_BAR; PG8_SCHED;
            PG8_LDA(At, 1, 1); PG8_STAGE(PG8_SB(1, 0), b3, voffB); PG8_STAGE(PG8_SB(1, 1), b3 + hstepB, voffB); PG8_STAGE(PG8_SA(1, 0), a3, voffA);
            PG8_WAIT_V(8); PG8_WAIT_L(0); PG8_BAR; PG8_MMA(1, 0, At, B0); PG8_MMA(1, 1, At, B1); PG8_BAR; PG8_SCHED;
        }
        if constexpr (ALIGN_EPI) { if (wr == 0) PG8_BAR; }
        E(acc, cur, wr, wc, fr, fq);
        if (!has_next) break;
#pragma unroll
        for (int a = 0; a < 2; ++a)
#pragma unroll
            for (int b = 0; b < 2; ++b)
#pragma unroll
                for (int m = 0; m < 4; ++m)
#pragma unroll
                    for (int n = 0; n < 2; ++n) acc[a][b][m][n] = (f32x4){0.f, 0.f, 0.f, 0.f};
        cur = nxt; cA = nA; cB = nB; ++ui;
        if constexpr (ALIGN_EPI) { if (wr == 1) PG8_BAR; }
    }
    PG8_WAIT_V(0);
    if constexpr (!ALIGN_EPI) { if (wr == 0) PG8_BAR; }
    PG8_BAR;
#undef PG8_SA
#undef PG8_SB
#undef PG8_STAGE
#undef PG8_LDA
#undef PG8_LDB
#undef PG8_MMA
#undef PG8_WAIT_V
#undef PG8_WAIT_L
#undef PG8_BAR
#undef PG8_SCHED
}
}

#ifndef PROBE_MASK
#define PROBE_MASK 0
#endif
#ifndef FAST_GEMM
#define FAST_GEMM 1
#endif


#define XB_TMO      128
#define XB_XCNT(j)  (256  + 64 * (j))
#define XB_XSUB(j)  (1280 + 64 * (j))
#define XB_XGEN(j)  (2304 + 64 * (j))
#define XB_TOP      3328
#define XB_TOPGEN   3392
#define XCD_BAR_WORDS 3456
#define XB_SPIN_CAP (1u << 20)
__device__ __forceinline__ unsigned xb_ld(unsigned* p)              { return __hip_atomic_load(p, __ATOMIC_RELAXED, __HIP_MEMORY_SCOPE_AGENT); }
__device__ __forceinline__ unsigned xb_add(unsigned* p, unsigned v) { return __hip_atomic_fetch_add(p, v, __ATOMIC_RELAXED, __HIP_MEMORY_SCOPE_AGENT); }
__device__ __forceinline__ unsigned xb_xcc_id() { return (unsigned)__builtin_amdgcn_s_getreg((3 << 11) | 20) & 0xFu; }
#define XB_SPIN(cond, bar) do { unsigned _sp = 0; while (cond) { __builtin_amdgcn_s_sleep(1); \
    if ((++_sp & 255u) == 0u) { if (xb_ld(&(bar)[XB_TMO])) break; if (_sp > XB_SPIN_CAP) { atomicAdd(&(bar)[XB_TMO], 1u); break; } } } } while (0)
struct XcdBarrier { unsigned* bar; unsigned x; volatile LAS unsigned* st; };
__device__ __forceinline__ XcdBarrier xcd_barrier_post(unsigned* bar, volatile LAS unsigned* st) {
    XcdBarrier b; b.bar = bar; b.x = xb_xcc_id(); b.st = st;
    if (threadIdx.x == 0) (void)xb_add(&bar[XB_XCNT(b.x)], 1u);
    return b;
}
__device__ __forceinline__ void xcd_barrier_complete(unsigned* bar, unsigned x, unsigned& nloc, unsigned& nx) {
    const unsigned G = gridDim.x * gridDim.y * gridDim.z;
    unsigned sum, cnt, mine, sp = 0u;
    for (;;) {
        sum = 0u; cnt = 0u; mine = 0u;
#pragma unroll
        for (unsigned j = 0; j < 16; ++j) { const unsigned c = xb_ld(&bar[XB_XCNT(j)]); sum += c; cnt += (c > 0u) ? 1u : 0u; mine = (j == x) ? c : mine; }
        if (sum == G) break;
        __builtin_amdgcn_s_sleep(1);
        if ((++sp & 255u) == 0u) { if (xb_ld(&bar[XB_TMO])) break; if (sp > XB_SPIN_CAP) { atomicAdd(&bar[XB_TMO], 1u); break; } }
    }
    nloc = mine > 0u ? mine : 1u; nx = cnt > 0u ? cnt : 1u;
}
__device__ __forceinline__ void xcd_barrier(const XcdBarrier& b) {
    asm volatile("s_waitcnt vmcnt(0)" ::: "memory");
    __syncthreads();
    if (threadIdx.x == 0) {
        unsigned* bar = b.bar;
        __builtin_amdgcn_s_waitcnt(0);
        unsigned nloc = b.st[0], nx = b.st[1];
        if (nloc == 0u) { xcd_barrier_complete(bar, b.x, nloc, nx); b.st[0] = nloc; b.st[1] = nx; }
        const unsigned old = xb_add(&bar[XB_XSUB(b.x)], 1u);
        const unsigned gen = old / nloc;
        if (old + 1u == (gen + 1u) * nloc) {
            __builtin_amdgcn_fence(__ATOMIC_RELEASE, "agent");
            asm volatile("s_waitcnt vmcnt(0)" ::: "memory");
            const unsigned og = xb_add(&bar[XB_TOP], 1u);
            const unsigned tg = og / nx;
            if (og + 1u == (tg + 1u) * nx) xb_add(&bar[XB_TOPGEN], 1u);
            else XB_SPIN(xb_ld(&bar[XB_TOPGEN]) == tg, bar);
            __builtin_amdgcn_fence(__ATOMIC_ACQUIRE, "agent");
            xb_add(&bar[XB_XGEN(b.x)], 1u);
            asm volatile("s_waitcnt vmcnt(0)" ::: "memory");
        } else {
            XB_SPIN(xb_ld(&bar[XB_XGEN(b.x)]) == gen, bar);
            __builtin_amdgcn_fence(__ATOMIC_ACQUIRE, "agent");
            asm volatile("s_waitcnt vmcnt(0)" ::: "memory");
        }
    }
    __syncthreads();
}

__global__ void __launch_bounds__(NTHR, 2) mk_fwd(Args a) {
    extern __shared__ __attribute__((aligned(16))) unsigned char lds_raw[];
    LAS unsigned char* lds = (LAS unsigned char*)lds_raw;
    const int tid = threadIdx.x, lane = tid & 63, wave = __builtin_amdgcn_readfirstlane(tid >> 6), G = gridDim.x;
    const int lo = a.ph_lo, hi = a.ph_hi;
    unsigned char* ws = a.ws;
    const float* MOD0 = (const float*)(ws + WS_MOD); const float* MOD1 = MOD0 + 9 * 6144;
#define IN(k) (lo <= (k) && (k) < hi)
#define REP(k) for (int rep_ = 0; rep_ < 1 + ((PROBE_MASK >> (k)) & 1); ++rep_, ((PROBE_MASK >> (k)) & 1) && rep_ == 1 ? xcd_barrier(xbar) : (void)0)
#define SEAM(k) do { if (IN(k) && IN((k) + 1)) { xcd_barrier(xbar); } } while (0)
    {
        volatile LAS unsigned* st = (volatile LAS unsigned*)(lds + LDS_BYTES - 64);
        if (tid < 16) st[tid] = 0u;
        __syncthreads();
    }
    XcdBarrier xbar = xcd_barrier_post((unsigned*)(ws + WS_CTL) + 4096, (volatile LAS unsigned*)(lds + LDS_BYTES - 64));

    if (IN(0)) REP(0) { p0_prep(a, lds, tid, lane, wave, G); } SEAM(0);
    if (IN(1)) REP(1) { p1_norm_mod(a, lane, wave, G); } SEAM(1);
#if FAST_GEMM
    if (IN(2)) REP(2) { pg8::Gemm g{(const bf16*)(ws + WS_A), (const bf16*)(ws + WS_WIN), D, D, D, 0}; pg8::StaticOrder S; S.init(MALL / 256, NPROJ_PAD / 256, G, (int)blockIdx.x);
        pg8::EpiInProj E{(bf16*)(ws + WS_Q), (bf16*)(ws + WS_K), (bf16*)(ws + WS_V), (bf16*)(ws + WS_O), (float*)(ws + WS_G), a.in[15]};
        pg8::gemm_phase<pg8::EpiInProj>(lds, g, S, E); } SEAM(2);
#else
    if (IN(2)) REP(2) { p2_inproj_simple(a, lds, tid, G); } SEAM(2);
#endif
#if FAST_MLSTM
    if (IN(3)) REP(3) { ml::mlstm_phase(a, lds, tid, lane, wave, G); } SEAM(3);
#else
    if (IN(3)) REP(3) { p3_mlstm_simple(a, lds, tid, G); } SEAM(3);
#endif
    if (IN(4)) REP(4) { p4_readout(a, lane, wave, G); } SEAM(4);
#if FAST_GEMM
    if (IN(5)) REP(5) { pg8::Gemm g{(const bf16*)(ws + WS_Y), (const bf16*)(ws + WS_WOUT), D, D, D, 0}; pg8::StaticOrder S; S.init(ML / 256, D / 256, G, (int)blockIdx.x);
        pg8::EpiF32 E{(float*)(ws + WS_Y1), D, nullptr}; pg8::gemm_phase<pg8::EpiF32>(lds, g, S, E); } SEAM(5);
#else
    if (IN(5)) REP(5) { gemm_simple_f32((const bf16*)(ws + WS_Y), D, (const bf16*)(ws + WS_WOUT), D, ML, D, D, (float*)(ws + WS_Y1), D, nullptr, lds, tid, G); } SEAM(5);
#endif
    if (IN(6)) REP(6) { rowpass<1>((const float*)(ws + WS_Y1), a.in[0], a.out, MOD0 + 2 * D, a.in[7], a.in[8], MOD0 + 3 * D, MOD0 + 4 * D, (bf16*)(ws + WS_H2), lane, wave, G); } SEAM(6);
#if FAST_GEMM
    if (IN(7)) REP(7) { pg8::Gemm g{(const bf16*)(ws + WS_H2), (const bf16*)(ws + WS_WUP), D, D, D, 0}; pg8::StaticOrder S; S.init(ML / 256, NUP / 256, G, (int)blockIdx.x);
        pg8::EpiUpConv E{(bf16*)(ws + WS_ACT), a.in[11], a.in[12]}; pg8::gemm_phase<pg8::EpiUpConv>(lds, g, S, E); } SEAM(7);
    if (IN(8)) REP(8) { pg8::Gemm g{(const bf16*)(ws + WS_ACT), (const bf16*)(ws + WS_WDN), FF, FF, FF, 0}; pg8::StaticOrder S; S.init(ML / 256, D / 256, G, (int)blockIdx.x);
        pg8::EpiF32 E{(float*)(ws + WS_Y2), D, nullptr}; pg8::gemm_phase<pg8::EpiF32>(lds, g, S, E); } SEAM(8);
#else
    if (IN(7)) REP(7) { p7_up_simple((const bf16*)(ws + WS_H2), (const bf16*)(ws + WS_WUP), a.in[11], a.in[12], (bf16*)(ws + WS_ACT), lds, tid, G); } SEAM(7);
    if (IN(8)) REP(8) { gemm_simple_f32((const bf16*)(ws + WS_ACT), FF, (const bf16*)(ws + WS_WDN), FF, ML, D, FF, (float*)(ws + WS_Y2), D, nullptr, lds, tid, G); } SEAM(8);
#endif
    if (IN(9)) REP(9) { rowpass_t((const float*)(ws + WS_Y2), a.out, a.out, MOD0 + 5 * D, a.in[9], a.in[6] + D, MOD1, MOD1 + D, (bf16*)(ws + WS_HT), lds, tid, lane, wave, G); } SEAM(9);
#if FAST_GEMM
    if (IN(10)) REP(10) { pg8::Gemm g{(const bf16*)(ws + WS_DFT), (const bf16*)(ws + WS_HT), 2048, 2048, 2048, 1}; pg8::StaticOrder S; S.init(NB * 16, 4, G, (int)blockIdx.x);
        pg8::EpiSeqMix E{(bf16*)(ws + WS_PQ)}; pg8::gemm_phase<pg8::EpiSeqMix>(lds, g, S, E); } SEAM(10);
    if (IN(11)) REP(11) { pg8::Gemm g{(const bf16*)(ws + WS_PQ), (const bf16*)(ws + WS_WCS), 2048, 2048, 2048, 0}; pg8::StaticOrder S; S.init(ML / 256, D / 256, G, (int)blockIdx.x);
        pg8::EpiF32 E{(float*)(ws + WS_Y3), D, a.in[19]}; pg8::gemm_phase<pg8::EpiF32>(lds, g, S, E); } SEAM(11);
#else
    if (IN(10)) REP(10) { p10_seqmix_simple(a, lds, tid, G); } SEAM(10);
    if (IN(11)) REP(11) { gemm_simple_f32((const bf16*)(ws + WS_PQ), 2048, (const bf16*)(ws + WS_WCS), 2048, ML, D, 2048, (float*)(ws + WS_Y3), D, a.in[19], lds, tid, G); } SEAM(11);
#endif
    if (IN(12)) REP(12) { rowpass<1>((const float*)(ws + WS_Y3), a.out, a.out, MOD1 + 2 * D, a.in[7] + D, a.in[8] + D, MOD1 + 3 * D, MOD1 + 4 * D, (bf16*)(ws + WS_H2B), lane, wave, G); } SEAM(12);
#if FAST_GEMM
    if (IN(13)) REP(13) { pg8::Gemm g{(const bf16*)(ws + WS_H2B), (const bf16*)(ws + WS_WUP) + (size_t)NUP * D, D, D, D, 0}; pg8::StaticOrder S; S.init(ML / 256, NUP / 256, G, (int)blockIdx.x);
        pg8::EpiUpConv E{(bf16*)(ws + WS_ACT1), a.in[11] + 3 * FF, a.in[12] + FF}; pg8::gemm_phase<pg8::EpiUpConv>(lds, g, S, E); } SEAM(13);
    if (IN(14)) REP(14) { pg8::Gemm g{(const bf16*)(ws + WS_ACT1), (const bf16*)(ws + WS_WDN) + (size_t)D * FF, FF, FF, FF, 0}; pg8::StaticOrder S; S.init(ML / 256, D / 256, G, (int)blockIdx.x);
        pg8::EpiF32 E{(float*)(ws + WS_Y2B), D, nullptr}; pg8::gemm_phase<pg8::EpiF32>(lds, g, S, E); } SEAM(14);
#else
    if (IN(13)) REP(13) { p7_up_simple((const bf16*)(ws + WS_H2B), (const bf16*)(ws + WS_WUP) + (size_t)NUP * D, a.in[11] + 3 * FF, a.in[12] + FF, (bf16*)(ws + WS_ACT1), lds, tid, G); } SEAM(13);
    if (IN(14)) REP(14) { gemm_simple_f32((const bf16*)(ws + WS_ACT1), FF, (const bf16*)(ws + WS_WDN) + (size_t)D * FF, FF, ML, D, FF, (float*)(ws + WS_Y2B), D, nullptr, lds, tid, G); } SEAM(14);
#endif
    if (IN(15)) REP(15) { rowpass<0>((const float*)(ws + WS_Y2B), a.out, a.out, MOD1 + 5 * D, a.in[9] + D, nullptr, nullptr, nullptr, nullptr, lane, wave, G); }
#undef IN
#undef SEAM
}

extern "C" void kernel_launch(void* const* d_in, const int* in_sizes, int n_in, void* d_out, int out_size, void* d_ws, size_t ws_size, hipStream_t stream) {
    static int grid = 0;
    if (grid == 0) {
        if (n_in != 20 || out_size != ML * D || ws_size < WS_END) { fprintf(stderr, "kernel_launch: unexpected shapes (n_in %d out %d ws %zu)\n", n_in, out_size, ws_size); grid = -1; return; }
        int dev = 0, cus = 0, per_cu = 0;
        (void)hipGetDevice(&dev); (void)hipDeviceGetAttribute(&cus, hipDeviceAttributeMultiprocessorCount, dev);
        (void)hipFuncSetAttribute((const void*)mk_fwd, hipFuncAttributeMaxDynamicSharedMemorySize, LDS_BYTES);
        (void)hipOccupancyMaxActiveBlocksPerMultiprocessor(&per_cu, (const void*)mk_fwd, NTHR, LDS_BYTES);
        if (per_cu < 1) { fprintf(stderr, "kernel_launch: occupancy query says %d blocks/CU\n", per_cu); per_cu = 1; }
        grid = cus * 1;
        (void)hipGetLastError();
    }
    if (grid < 0) return;
    (void)hipMemsetAsync((char*)d_ws + WS_CTL, 0, 1 * MiB, stream);
    Args a{};
    for (int i = 0; i < 20; ++i) a.in[i] = (const float*)d_in[i];
    a.out = (float*)d_out; a.ws = (unsigned char*)d_ws;
    if (MK_N_LAUNCHES == 1) {
        a.ph_lo = 0; a.ph_hi = NPH;
        void* args[] = {&a};
        hipError_t e = hipLaunchCooperativeKernel((const void*)mk_fwd, dim3(grid), dim3(NTHR), args, LDS_BYTES, stream);
        if (e != hipSuccess) fprintf(stderr, "cooperative launch failed: %s (grid %d)\n", hipGetErrorString(e), grid);
    } else {
        for (int p = 0; p < NPH; ++p) { a.ph_lo = p; a.ph_hi = p + 1;
            hipLaunchKernelGGL(mk_fwd, dim3(grid), dim3(NTHR), LDS_BYTES, stream, a); }
    }
}
```
